# Optimizing an MI355X kernel written in HIP

```python
import jax, jax.numpy as jnp
from jax import lax
import numpy as np


D_MODEL = 1024
BATCH = 8
SEQ = 4096
DEPTH = 1

ATTN_HEAD_DIM = 64
ATTN_WIDTH = D_MODEL // 2
ATTN_HEADS = ATTN_WIDTH // ATTN_HEAD_DIM
DILATION_PATTERNS = ((128, 1), (512, 4), (2048, 16))
ATTN_BLOCK = 128
REL_BUCKETS = 32
REL_MAX_DISTANCE = 2048

HGRN_HEAD_DIM = 128
HGRN_WIDTH = D_MODEL - ATTN_WIDTH
HGRN_HEADS = HGRN_WIDTH // HGRN_HEAD_DIM
HGRN_CHUNK = 64

MIX_WIDTH = ATTN_WIDTH + HGRN_WIDTH
IN_SPLITS = (ATTN_WIDTH, 2 * ATTN_WIDTH, 3 * ATTN_WIDTH,
             3 * ATTN_WIDTH + HGRN_WIDTH, 3 * ATTN_WIDTH + 2 * HGRN_WIDTH,
             3 * ATTN_WIDTH + 3 * HGRN_WIDTH)
IN_PROJ_WIDTH = 3 * ATTN_WIDTH + 4 * HGRN_WIDTH

N_EXPERTS = 32
TOP_K = 4
D_EXPERT = D_MODEL
SWIGLU_LIMIT = 7.0
SWIGLU_ALPHA = 1.702
EXPERT_BLOCK = 128
RMS_EPS = 1e-5

kernel_name = 'hybrid_dilated_attn_hgrn2_moe_block'


def rms_norm(x, w):
    xf = x.astype(jnp.float32)
    y = xf * lax.rsqrt(jnp.mean(xf * xf, axis=-1, keepdims=True) + RMS_EPS)
    return (y * w.astype(jnp.float32)).astype(x.dtype)


def t5_causal_bucket(dist):
    n = np.maximum(dist, 0)
    max_exact = REL_BUCKETS // 2
    large = max_exact + (np.log(np.maximum(n, 1) / max_exact)
                         / np.log(REL_MAX_DISTANCE / max_exact)
                         * (REL_BUCKETS - max_exact)).astype(np.int32)
    large = np.minimum(large, REL_BUCKETS - 1)
    return np.where(n < max_exact, n, large).astype(np.int32)


def dilated_window_attention(q, k, v, rel_bias, window, dilation):
    b, h, s, hd = q.shape
    blk = ATTN_BLOCK
    span = window // dilation
    unit = blk * dilation
    s_pad = -(-s // unit) * unit
    n_sub = s_pad // dilation
    nb = n_sub // blk

    def to_blocks(t):
        t = jnp.pad(t, ((0, 0), (0, 0), (0, s_pad - s), (0, 0)))
        t = t.reshape(b, h, n_sub, dilation, hd).transpose(0, 1, 3, 2, 4)
        return t.reshape(b, h, dilation, nb, blk, hd)

    def with_prev(t):
        prev = jnp.pad(t[:, :, :, :-1], ((0, 0), (0, 0), (0, 0), (1, 0), (0, 0), (0, 0)))
        return jnp.concatenate([prev, t], axis=-2)

    qb = to_blocks(q)
    kk = with_prev(to_blocks(k))
    vv = with_prev(to_blocks(v))

    qi = np.arange(blk)[:, None]
    kj = np.arange(2 * blk)[None, :]
    dist_sub = blk + qi - kj
    band = (dist_sub >= 0) & (dist_sub <= span)
    valid = band[None] & ((np.arange(nb)[:, None, None] > 0) | (kj[None] >= blk))
    buckets = t5_causal_bucket(dist_sub * dilation)
    bias = jnp.transpose(rel_bias[buckets], (2, 0, 1)).astype(jnp.float32)

    scores = jnp.einsum('bhrnqe,bhrnke->bhrnqk', qb, kk).astype(jnp.float32) * (hd ** -0.5)
    scores = scores + bias[None, :, None, None]
    scores = jnp.where(valid, scores, -1e30)
    m = jnp.max(scores, axis=-1, keepdims=True)
    p = jnp.exp(scores - m)
    z = jnp.sum(p, axis=-1, keepdims=True)
    out = jnp.einsum('bhrnqk,bhrnke->bhrnqe', p, vv.astype(jnp.float32)) / z
    lse = (m + jnp.log(z))[..., 0]

    out = out.reshape(b, h, dilation, n_sub, hd).transpose(0, 1, 3, 2, 4).reshape(b, h, s_pad, hd)[:, :, :s]
    lse = lse.reshape(b, h, dilation, n_sub).transpose(0, 1, 3, 2).reshape(b, h, s_pad)[:, :, :s]
    return out, lse


def hgrn2_chunkwise(q, f_logit, i, lower_bound):
    b, s, h, dk = q.shape
    dv = i.shape[-1]
    c = HGRN_CHUNK
    nc = s // c
    lb = lower_bound.astype(jnp.float32)
    f = lb + (1.0 - lb) * jax.nn.sigmoid(f_logit.astype(jnp.float32))
    log_f = jnp.log(f)
    key = 1.0 - f
    qf = jax.nn.silu(q.astype(jnp.float32)) * (dk ** -0.5)

    def chunks(t):
        return t.astype(jnp.float32).reshape(b, nc, c, h, t.shape[-1]).transpose(1, 0, 3, 2, 4)

    causal = jnp.tril(jnp.ones((c, c), dtype=bool))

    def step(state, inp):
        qc, kc, vc, gc = inp
        cum = jnp.cumsum(gc, axis=-2)
        o_inter = jnp.einsum('bhtk,bhkv->bhtv', qc * jnp.exp(cum), state)
        diff = cum[:, :, :, None, :] - cum[:, :, None, :, :]
        decay = jnp.exp(jnp.where(causal[:, :, None], diff, -jnp.inf))
        attn = jnp.einsum('bhtk,bhsk,bhtsk->bhts', qc, kc, decay)
        o_intra = jnp.einsum('bhts,bhsv->bhtv', attn, vc)
        last = cum[:, :, -1:, :]
        state = (jnp.exp(last[:, :, 0, :])[..., None] * state
                 + jnp.einsum('bhsk,bhsv->bhkv', kc * jnp.exp(last - cum), vc))
        return state, o_inter + o_intra

    s0 = jnp.zeros((b, h, dk, dv), jnp.float32)
    _, o = lax.scan(step, s0, (chunks(qf), chunks(key), chunks(i), chunks(log_f)))
    return o.transpose(1, 0, 3, 2, 4).reshape(b, s, h, dv)


def token_mixer(xn, w_in_l, rel_bias, lower_bound_l, hgrn_norm_w_l, w_out_l):
    b, s, _ = xn.shape
    proj = xn @ w_in_l
    q_a, k_a, v_a, q_h, f_h, i_h, g_h = jnp.split(proj, IN_SPLITS, axis=-1)

    def attn_heads(t):
        return t.reshape(b, s, ATTN_HEADS, ATTN_HEAD_DIM).transpose(0, 2, 1, 3)

    qa, ka, va = attn_heads(q_a), attn_heads(k_a), attn_heads(v_a)
    outs, lses = [], []
    for window, dilation in DILATION_PATTERNS:
        o, l = dilated_window_attention(qa, ka, va, rel_bias, window, dilation)
        outs.append(o)
        lses.append(l)
    weights = jax.nn.softmax(jnp.stack(lses), axis=0)
    attn = jnp.einsum('pbhs,pbhse->bshe', weights, jnp.stack(outs)).reshape(b, s, ATTN_WIDTH)

    def hgrn_heads(t):
        return t.reshape(b, s, HGRN_HEADS, HGRN_HEAD_DIM)

    hg = hgrn2_chunkwise(hgrn_heads(q_h), hgrn_heads(f_h), hgrn_heads(i_h),
                         lower_bound_l.reshape(HGRN_HEADS, HGRN_HEAD_DIM))
    hg = rms_norm(hg, hgrn_norm_w_l) * jax.nn.silu(hgrn_heads(g_h).astype(jnp.float32))

    mix = jnp.concatenate([attn.astype(xn.dtype), hg.reshape(b, s, HGRN_WIDTH).astype(xn.dtype)], axis=-1)
    return (mix @ w_out_l).astype(xn.dtype)


def expert_ffn(xn, router_w_l, router_b_l, w_gu_l, b_gu_l, w_dn_l, b_dn_l):
    b, s, d = xn.shape
    tokens = xn.reshape(b * s, d)
    n = b * s
    nk = n * TOP_K
    logits = (tokens @ router_w_l).astype(jnp.float32) + router_b_l.astype(jnp.float32)
    top_vals, top_idx = lax.top_k(logits, TOP_K)
    gates = jax.nn.softmax(top_vals, axis=-1)

    flat_e = top_idx.reshape(-1)
    flat_tok = jnp.arange(nk, dtype=jnp.int32) // TOP_K
    flat_g = gates.reshape(-1)
    order = jnp.argsort(flat_e)
    sorted_e = flat_e[order]
    counts = jnp.zeros((N_EXPERTS,), jnp.int32).at[flat_e].add(1)
    padded = (counts + EXPERT_BLOCK - 1) // EXPERT_BLOCK * EXPERT_BLOCK
    start = jnp.cumsum(counts) - counts
    pend = jnp.cumsum(padded)
    pstart = pend - padded
    dest = pstart[sorted_e] + (jnp.arange(nk, dtype=jnp.int32) - start[sorted_e])

    n_blocks = -(-nk // EXPERT_BLOCK) + N_EXPERTS
    cap = n_blocks * EXPERT_BLOCK
    tok_buf = jnp.full((cap,), n, jnp.int32).at[dest].set(flat_tok[order])
    gate_buf = jnp.zeros((cap,), jnp.float32).at[dest].set(flat_g[order])
    block_e = jnp.clip(jnp.searchsorted(pend, jnp.arange(n_blocks, dtype=jnp.int32) * EXPERT_BLOCK,
                                        side='right'), 0, N_EXPERTS - 1)
    tokens_pad = jnp.concatenate([tokens, jnp.zeros((1, d), tokens.dtype)], axis=0)

    def expert_block(args):
        ids, e = args
        xb = tokens_pad[ids]
        hgu = xb @ w_gu_l[e] + b_gu_l[e]
        gate = jnp.minimum(hgu[:, :D_EXPERT], SWIGLU_LIMIT)
        up = jnp.clip(hgu[:, D_EXPERT:], -SWIGLU_LIMIT, SWIGLU_LIMIT)
        act = gate * jax.nn.sigmoid(SWIGLU_ALPHA * gate) * (up + 1.0)
        return act @ w_dn_l[e] + b_dn_l[e]

    out_blocks = lax.map(expert_block, (tok_buf.reshape(n_blocks, EXPERT_BLOCK), block_e))
    y = jnp.zeros((n + 1, d), jnp.float32).at[tok_buf].add(
        out_blocks.reshape(cap, d).astype(jnp.float32) * gate_buf[:, None])
    return y[:n].reshape(b, s, d).astype(xn.dtype)


def setup_inputs(seed: int = 0) -> dict:
    key = jax.random.key(seed)
    ks = jax.random.split(key, 16)
    f32 = jnp.float32

    def nrm(k, shape, scale):
        return jax.random.normal(k, shape, f32) * scale

    return {
        'x': nrm(ks[0], (BATCH, SEQ, D_MODEL), 1.0),
        'norm_mix_w': 1.0 + nrm(ks[1], (DEPTH, D_MODEL), 0.02),
        'w_in': nrm(ks[2], (DEPTH, D_MODEL, IN_PROJ_WIDTH), D_MODEL ** -0.5),
        'rel_bias': nrm(ks[3], (REL_BUCKETS, ATTN_HEADS), 0.5),
        'hgrn_lb_logits': nrm(ks[4], (DEPTH + 1, HGRN_WIDTH), 1.0),
        'hgrn_norm_w': 1.0 + nrm(ks[5], (DEPTH, HGRN_HEAD_DIM), 0.02),
        'w_out': nrm(ks[6], (DEPTH, MIX_WIDTH, D_MODEL), MIX_WIDTH ** -0.5),
        'norm_ffn_w': 1.0 + nrm(ks[7], (DEPTH, D_MODEL), 0.02),
        'router_w': nrm(ks[8], (DEPTH, D_MODEL, N_EXPERTS), D_MODEL ** -0.5),
        'router_b': nrm(ks[9], (DEPTH, N_EXPERTS), 0.01),
        'w_gate_up': nrm(ks[10], (DEPTH, N_EXPERTS, D_MODEL, 2 * D_EXPERT), D_MODEL ** -0.5),
        'b_gate_up': nrm(ks[11], (DEPTH, N_EXPERTS, 2 * D_EXPERT), 0.01),
        'w_down': nrm(ks[12], (DEPTH, N_EXPERTS, D_EXPERT, D_MODEL), D_EXPERT ** -0.5),
        'b_down': nrm(ks[13], (DEPTH, N_EXPERTS, D_MODEL), 0.01),
        'final_norm_w': 1.0 + nrm(ks[14], (D_MODEL,), 0.02),
    }


def reference(x, norm_mix_w, w_in, rel_bias, hgrn_lb_logits, hgrn_norm_w, w_out, norm_ffn_w,
              router_w, router_b, w_gate_up, b_gate_up, w_down, b_down, final_norm_w):
    lower_bounds = jnp.cumsum(jax.nn.softmax(hgrn_lb_logits.astype(jnp.float32), axis=0), axis=0)
    h = x
    for layer in range(DEPTH):
        h = h + token_mixer(rms_norm(h, norm_mix_w[layer]), w_in[layer], rel_bias,
                            lower_bounds[layer], hgrn_norm_w[layer], w_out[layer])
        h = h + expert_ffn(rms_norm(h, norm_ffn_w[layer]), router_w[layer], router_b[layer],
                           w_gate_up[layer], b_gate_up[layer], w_down[layer], b_down[layer])
    return rms_norm(h, final_norm_w)
```

```cpp
#include <hip/hip_runtime.h>
#include <cstdio>
#include <cstdint>
#include <cmath>

#define GAS __attribute__((address_space(1)))
#define LAS __attribute__((address_space(3)))
typedef unsigned short bf16;
typedef unsigned v4u __attribute__((ext_vector_type(4)));
typedef unsigned v2u __attribute__((ext_vector_type(2)));
typedef float f32x4 __attribute__((ext_vector_type(4)));
typedef float f32x2 __attribute__((ext_vector_type(2)));
typedef short bf16x8 __attribute__((ext_vector_type(8)));
typedef GAS unsigned gu32;
#define RLX_AGENT __ATOMIC_RELAXED, __HIP_MEMORY_SCOPE_AGENT
#define LDS_WAIT() asm volatile("s_waitcnt lgkmcnt(0)" ::: "memory")
#define VM_WAIT() asm volatile("s_waitcnt vmcnt(0)" ::: "memory")

constexpr int D = 1024, BATCH = 8, SEQ = 4096, M = BATCH * SEQ;
constexpr int AH = 8, HD = 64;
constexpr int HH = 4, HK = 128;
constexpr int NPROJ = 3584;
constexpr int NE = 32, TOPK = 4;
constexpr int ECAP = 32768;
constexpr float RMS_EPS = 1e-5f;
constexpr float LOG2E = 1.4426950408889634f, LN2 = 0.6931471805599453f;
constexpr float QSCALE = 0.125f * LOG2E;

constexpr size_t MiB = 1u << 20;
constexpr size_t WS_CTL = 0, CTL_ZERO_BYTES = 48 * 1024;
constexpr size_t WS_LB = 1 * MiB;
constexpr size_t WS_WR = 1 * MiB + 65536;
constexpr size_t WS_WIN = 2 * MiB;
constexpr size_t WS_WOUT = 9 * MiB;
constexpr size_t WS_TOK = 11 * MiB, WS_SLOT = 15 * MiB, WS_GATE = 19 * MiB, WS_RS = 23 * MiB;
constexpr size_t WS_LSE = 27 * MiB;
constexpr size_t WS_WDN = 32 * MiB;
constexpr size_t WS_WGU = 96 * MiB;
constexpr size_t WS_XN = 224 * MiB;
constexpr size_t WS_MIX = 288 * MiB;
constexpr size_t WS_HB = 160 * MiB;
constexpr size_t WS_OBUF = 488 * MiB;
constexpr size_t WS_PROJ = 352 * MiB;
constexpr size_t WS_ATTP = 576 * MiB;
constexpr size_t WS_ACT = 352 * MiB;
constexpr size_t WS_HO = 672 * MiB;
constexpr size_t WS_END = 736 * MiB;
constexpr size_t PROJ_STRIDE = (size_t)M * 512;
constexpr int CW_TMO = 0, CW_CODE = 1, CW_BAR = 4096, CW_CNT = 8192;
static_assert((CW_BAR + 3456) <= CW_CNT && (size_t)(CW_CNT + 64 * 32) * 4 <= CTL_ZERO_BYTES, "control words inside the per-call memset");

constexpr int RING_BYTES = 131072;
constexpr int ROWS_OFF = RING_BYTES;
constexpr int MAXU = 20;
constexpr int TAB_OFF = ROWS_OFF + MAXU * 1024;
constexpr int CNT_OFF = TAB_OFF + MAXU * 32;
constexpr int MISC_OFF = CNT_OFF + 256;
constexpr int CB_OFF = MISC_OFF + 128;
constexpr int LDS_BYTES = 159744;
static_assert(CB_OFF % 16 == 0 && CB_OFF + 4096 <= LDS_BYTES, "LDS map");
constexpr int NWAVES = 8;

__device__ __forceinline__ unsigned f2bf(float f) { unsigned u = __builtin_bit_cast(unsigned, f); return (u + 0x7fffu + ((u >> 16) & 1u)) >> 16; }
__device__ __forceinline__ unsigned pk2(float lo, float hi) { unsigned r; asm volatile("v_cvt_pk_bf16_f32 %0, %1, %2" : "=v"(r) : "v"(lo), "v"(hi)); return r; }
__device__ __forceinline__ float bf2f(unsigned b) { return __builtin_bit_cast(float, b << 16); }
__device__ __forceinline__ float bflo(unsigned w) { return __builtin_bit_cast(float, w << 16); }
__device__ __forceinline__ float bfhi(unsigned w) { return __builtin_bit_cast(float, w & 0xffff0000u); }
typedef int v8i_t __attribute__((ext_vector_type(8)));
typedef int v4i_t __attribute__((ext_vector_type(4)));
constexpr float X8S = 16.0f, W8S = 256.0f, A8S = 8.0f, O8S = 32.0f;
__device__ __forceinline__ float clamp448(float x) { return __builtin_amdgcn_fmed3f(x, -448.0f, 448.0f); }
__device__ __forceinline__ unsigned pk4_fp8(float a, float b, float c, float d) { int w = 0; w = __builtin_amdgcn_cvt_pk_fp8_f32(clamp448(a), clamp448(b), w, false); w = __builtin_amdgcn_cvt_pk_fp8_f32(clamp448(c), clamp448(d), w, true); return (unsigned)w; }
__device__ __forceinline__ float fexp2(float x) { return __builtin_amdgcn_exp2f(x); }
__device__ __forceinline__ float frcp(float x) { return __builtin_amdgcn_rcpf(x); }
__device__ __forceinline__ float sigmoidf_(float x) { return frcp(1.0f + fexp2(-x * LOG2E)); }
__device__ __forceinline__ float siluf_(float x) { return x * sigmoidf_(x); }

namespace pg8 {
typedef unsigned u32x4 __attribute__((ext_vector_type(4)));
constexpr int BM = 256, BK = 64, HALF = 128, HTB = HALF * BK * 2, STAGE_BYTES = 8 * HTB, NXCD = 8, WGM = 8;
__host__ __device__ __forceinline__ int lds_byte(int r, int c) { const int st = (r >> 4) * 2 + (c >> 5), rr = r & 15, cc = c & 31, ob = rr * 64 + cc * 2; return st * 1024 + (ob ^ (((ob >> 9) & 1) << 5)); }
__host__ __device__ __forceinline__ void stage_rc(int b, int& R, int& C) { const int st = b / 1024, sb = b % 1024, swz = sb ^ (((sb >> 9) & 1) << 5); R = (st >> 1) * 16 + swz / 64; C = (st & 1) * 32 + (swz % 64) / 2; }
__host__ __device__ __forceinline__ int perm32(int rho) { const int n = rho >> 4, i = rho & 15; return 8 * (i >> 2) + 4 * n + (i & 3); }

struct Unit { const char* A; const char* B; const LAS int* rows; int pm, pn, e, nvalid, rowbase; };
__device__ __forceinline__ unsigned cvt_pk_bf16(float lo, float hi) { unsigned r; asm volatile("v_cvt_pk_bf16_f32 %0, %1, %2" : "=v"(r) : "v"(lo), "v"(hi)); return r; }

struct DenseOrder {
    const char* A; const char* B; int K, nM, nN, nwg, G, c;
    __device__ __forceinline__ void init(const void* A_, const void* B_, int M_, int N_, int K_, int G_, int c_) { A = (const char*)A_; B = (const char*)B_; K = K_; nM = M_ / BM; nN = N_ / BM; nwg = nM * nN; G = G_; c = c_; }
    __device__ __forceinline__ bool next(int i, Unit& u) const {
        const long L = (long)i * G + c; if (L >= nwg) return false;
        int wgid = (int)L; { const int q = nwg / NXCD, r = nwg % NXCD, xcd = wgid % NXCD, off = wgid / NXCD; wgid = (xcd < r ? xcd * (q + 1) : r * (q + 1) + (xcd - r) * q) + off; }
        const int nig = WGM * nN, gid = wgid / nig, fm = gid * WGM, gsz = (nM - fm) < WGM ? (nM - fm) : WGM;
        u.pm = fm + ((wgid % nig) % gsz); u.pn = (wgid % nig) / gsz; u.e = 0; u.nvalid = 256; u.rowbase = 0; u.rows = nullptr;
        u.A = A + (size_t)u.pm * ((size_t)BM * K * 2); u.B = B + (size_t)u.pn * ((size_t)BM * K * 2); return true;
    }
};
struct MoeOrder {
    const LAS int* tab; const LAS int* rows; int n; const char* A; const char* B; size_t bstride; int K; bool gather;
    __device__ __forceinline__ bool next(int i, Unit& u) const {
        if (i >= n) return false;
        const LAS int* t = tab + i * 8;
        u.e = __builtin_amdgcn_readfirstlane(t[0]); u.pm = __builtin_amdgcn_readfirstlane(t[1]); u.pn = __builtin_amdgcn_readfirstlane(t[2]);
        u.nvalid = __builtin_amdgcn_readfirstlane(t[3]); u.rowbase = __builtin_amdgcn_readfirstlane(t[4]);
        u.B = B + (size_t)u.e * bstride + (size_t)u.pn * ((size_t)BM * K * 2);
        if (gather) { u.A = A; u.rows = rows + i * 256; }
        else { u.A = A + (size_t)(u.rowbase + u.pm * 256) * ((size_t)K * 2); u.rows = nullptr; }
        return true;
    }
};

template <class Epi, class Sched, bool GATHER, bool ALIGN_EPI, bool FP8 = false>
__device__ __forceinline__ void gemm_phase(LAS unsigned char* lds, const int K, const Sched& S, const Epi& E, LAS unsigned char* cbuf = nullptr) {
    const int tid = threadIdx.x, wid = __builtin_amdgcn_readfirstlane(tid >> 6), lane = tid & 63, wr = wid >> 2, wc = wid & 3, fr = lane & 15, fq = lane >> 4;
    const int nt = K / BK;
    unsigned voffA[2], voffB[2], cA2[2]; int rA[2];
#pragma unroll
    for (int i = 0; i < 2; ++i) { int R, C; stage_rc(tid * 16 + i * 8192, R, C); const int Rb = Epi::PERM ? ((R & ~31) + perm32(R & 31)) : R;
        voffA[i] = (unsigned)(R * K + C) * 2u; voffB[i] = (unsigned)(Rb * K + C) * 2u; rA[i] = R; cA2[i] = (unsigned)C * 2u; }
    const size_t kstep = (size_t)(BK * 2);
    const size_t hstep = (size_t)HALF * K * 2;
    const unsigned ldsw = (unsigned)wid * 1024u;
    const int aoff = lds_byte(wr * 64 + fr, fq * 8), boff = lds_byte(wc * 32 + fr, fq * 8);
#define PG8_SA(b, h) (((b) * 2 + (h)) * HTB)
#define PG8_SB(b, h) ((4 + (b) * 2 + (h)) * HTB)
#define PG8_STAGE(bufoff, gbase, voff) do { _Pragma("unroll") for (int _i = 0; _i < 2; ++_i) \
        __builtin_amdgcn_global_load_lds((const unsigned*)((const char*)(gbase) + (voff)[_i]), (LAS unsigned*)(lds + (bufoff) + ldsw + _i * 8192), 16, 0, 0); } while (0)
#define PG8_STAGE_A(b, h, aptr, G) do { if constexpr (GATHER) { PG8_STAGE(PG8_SA(b, h), aptr, G[h]); } else { PG8_STAGE(PG8_SA(b, h), (aptr) + (h) * hstep, voffA); } } while (0)
#define PG8_LD8(addr) __builtin_shufflevector(*(const LAS v4i_t*)(addr), *(const LAS v4i_t*)((addr) + 1024), 0, 1, 2, 3, 4, 5, 6, 7)
#define PG8_LDA(dst, b, h) do { if constexpr (FP8) { _Pragma("unroll") for (int m = 0; m < 4; ++m) dst##8[m] = PG8_LD8(lds + PG8_SA(b, h) + aoff + m * 2048); } \
        else { _Pragma("unroll") for (int m = 0; m < 4; ++m) _Pragma("unroll") for (int k = 0; k < 2; ++k) dst[m][k] = *(const LAS bf16x8*)(lds + PG8_SA(b, h) + aoff + m * 2048 + k * 1024); } } while (0)
#define PG8_LDB(dst, b, h) do { if constexpr (FP8) { _Pragma("unroll") for (int n = 0; n < 2; ++n) dst##8[n] = PG8_LD8(lds + PG8_SB(b, h) + boff + n * 2048); } \
        else { _Pragma("unroll") for (int n = 0; n < 2; ++n) _Pragma("unroll") for (int k = 0; k < 2; ++k) dst[n][k] = *(const LAS bf16x8*)(lds + PG8_SB(b, h) + boff + n * 2048 + k * 1024); } } while (0)
#define PG8_MMA(ai, bj, At, Bt) do { __builtin_amdgcn_s_setprio(1); \
        if constexpr (FP8) { _Pragma("unroll") for (int m = 0; m < 4; ++m) _Pragma("unroll") for (int n = 0; n < 2; ++n) \
            asm volatile("v_mfma_f32_16x16x128_f8f6f4 %0, %1, %2, %0" : "+v"(acc[ai][bj][m][n]) : "v"(Bt##8[n]), "v"(At##8[m])); } \
        else { _Pragma("unroll") for (int m = 0; m < 4; ++m) _Pragma("unroll") for (int n = 0; n < 2; ++n) _Pragma("unroll") for (int k = 0; k < 2; ++k) \
            acc[ai][bj][m][n] = __builtin_amdgcn_mfma_f32_16x16x32_bf16(Bt[n][k], At[m][k], acc[ai][bj][m][n], 0, 0, 0); } \
        __builtin_amdgcn_s_setprio(0); } while (0)
#define PG8_MMA0(ai, bj, At, Bt) do { __builtin_amdgcn_s_setprio(1); \
        if constexpr (FP8) { _Pragma("unroll") for (int m = 0; m < 4; ++m) _Pragma("unroll") for (int n = 0; n < 2; ++n) \
            asm volatile("v_mfma_f32_16x16x128_f8f6f4 %0, %1, %2, 0" : "=v"(acc[ai][bj][m][n]) : "v"(Bt##8[n]), "v"(At##8[m])); } \
        else { _Pragma("unroll") for (int m = 0; m < 4; ++m) _Pragma("unroll") for (int n = 0; n < 2; ++n) { \
            acc[ai][bj][m][n] = __builtin_amdgcn_mfma_f32_16x16x32_bf16(Bt[n][0], At[m][0], (f32x4){0.f, 0.f, 0.f, 0.f}, 0, 0, 0); \
            acc[ai][bj][m][n] = __builtin_amdgcn_mfma_f32_16x16x32_bf16(Bt[n][1], At[m][1], acc[ai][bj][m][n], 0, 0, 0); } } \
        __builtin_amdgcn_s_setprio(0); } while (0)
#define PG8_WAIT_V(n) asm volatile("s_waitcnt vmcnt(" #n ")" ::: "memory")
#define PG8_WAIT_L(n) asm volatile("s_waitcnt lgkmcnt(" #n ")" ::: "memory")
#define PG8_BAR __builtin_amdgcn_s_barrier()
#define PG8_SCHED __builtin_amdgcn_sched_barrier(0)
#define PG8_GLOAD(G, u) do { _Pragma("unroll") for (int _h = 0; _h < 2; ++_h) _Pragma("unroll") for (int _i = 0; _i < 2; ++_i) { int _r = rA[_i] + HALF * _h; _r = _r < (u).nvalid ? _r : 0; \
        G[_h][_i] = (unsigned)(u).rows[_r] * (unsigned)(K * 2) + cA2[_i]; } } while (0)
#define PG8_ITER(FIRSTV) do { constexpr bool FIRST_ = (FIRSTV); \
            const bool last = (t == nt - 2); \
            const char* a1 = cA + (size_t)(t + 1) * kstep; \
            const char* a2 = last ? nA : cA + (size_t)(t + 2) * kstep; const char* b2 = last ? nB : cB + (size_t)(t + 2) * kstep; \
            const char* a3 = a2 + kstep; const char* b3 = b2 + kstep; \
            const bool relax = (t == 0) && (ui > 0); \
            PG8_LDB(B0, 0, 0); PG8_LDB(B1, 0, 1); PG8_SCHED; PG8_LDA(At, 0, 0); PG8_STAGE_A(1, 1, a1, gc); \
            if constexpr (GATHER) { if (last && has_next) { PG8_GLOAD(gc, nxt); } } \
            if (relax) { asm volatile("s_waitcnt vmcnt(%0)" :: "n"(8 + Epi::NE) : "memory"); } else { PG8_WAIT_V(8); } \
            PG8_WAIT_L(0); PG8_BAR; if constexpr (FIRST_) { PG8_MMA0(0, 0, At, B0); PG8_MMA0(0, 1, At, B1); } else { PG8_MMA(0, 0, At, B0); PG8_MMA(0, 1, At, B1); } PG8_BAR; PG8_SCHED; \
            PG8_LDA(At, 0, 1); PG8_STAGE(PG8_SB(0, 0), b2, voffB); PG8_STAGE(PG8_SB(0, 1), b2 + hstep, voffB); PG8_STAGE_A(0, 0, a2, gc); \
            if (relax) { asm volatile("s_waitcnt vmcnt(%0)" :: "n"(8 + Epi::NE) : "memory"); } else { PG8_WAIT_V(8); } \
            PG8_WAIT_L(0); PG8_BAR; if constexpr (FIRST_) { PG8_MMA0(1, 0, At, B0); PG8_MMA0(1, 1, At, B1); } else { PG8_MMA(1, 0, At, B0); PG8_MMA(1, 1, At, B1); } PG8_BAR; PG8_SCHED; \
            PG8_LDB(B0, 1, 0); PG8_LDB(B1, 1, 1); PG8_SCHED; PG8_LDA(At, 1, 0); PG8_STAGE_A(0, 1, a2, gc); \
            PG8_WAIT_V(8); PG8_WAIT_L(0); PG8_BAR; PG8_MMA(0, 0, At, B0); PG8_MMA(0, 1, At, B1); PG8_BAR; PG8_SCHED; \
            PG8_LDA(At, 1, 1); PG8_STAGE(PG8_SB(1, 0), b3, voffB); PG8_STAGE(PG8_SB(1, 1), b3 + hstep, voffB); PG8_STAGE_A(1, 0, a3, gc); \
            PG8_WAIT_V(8); PG8_WAIT_L(0); PG8_BAR; PG8_MMA(1, 0, At, B0); PG8_MMA(1, 1, At, B1); PG8_BAR; PG8_SCHED; \
        } while (0)
    Unit cur, nxt; int ui = 0;
    if (!S.next(0, cur)) return;
    f32x4 acc[2][2][4][2];
    bf16x8 At[4][2], B0[2][2], B1[2][2]; v8i_t At8[4], B08[2], B18[2];
    unsigned gc[2][2] = {{0u, 0u}, {0u, 0u}};
    if constexpr (GATHER) { PG8_GLOAD(gc, cur); }
    const char* cA = cur.A; const char* cB = cur.B;
    PG8_STAGE(PG8_SB(0, 0), cB, voffB); PG8_STAGE(PG8_SB(0, 1), cB + hstep, voffB); PG8_STAGE_A(0, 0, cA, gc); PG8_STAGE_A(0, 1, cA, gc);
    if (wr == 1) PG8_BAR;
    PG8_WAIT_V(2); PG8_BAR;
    PG8_STAGE(PG8_SB(1, 0), cB + kstep, voffB); PG8_STAGE_A(1, 0, cA + kstep, gc); PG8_STAGE(PG8_SB(1, 1), cB + hstep + kstep, voffB);
    PG8_WAIT_V(6); PG8_BAR;
    for (;;) {
        if constexpr (Epi::HAS_PF) { if (wid == 0) E.prefetch(cur, cbuf + (ui & 1) * 2048, lane); }
        const bool has_next = S.next(ui + 1, nxt);
        const char* nA = has_next ? nxt.A : cA; const char* nB = has_next ? nxt.B : cB;
        if constexpr (FP8) {
            { const int t = 0; PG8_ITER(true); }
#pragma unroll 1
            for (int t = 2; t < nt; t += 2) { PG8_ITER(false); }
        } else {
#pragma unroll
            for (int a = 0; a < 2; ++a)
#pragma unroll
                for (int b = 0; b < 2; ++b)
#pragma unroll
                    for (int m = 0; m < 4; ++m)
#pragma unroll
                        for (int n = 0; n < 2; ++n) acc[a][b][m][n] = (f32x4){0.f, 0.f, 0.f, 0.f};
#pragma unroll 1
            for (int t = 0; t < nt; t += 2) { PG8_ITER(false); }
        }
        if constexpr (ALIGN_EPI) { if (wr == 0) PG8_BAR; }
        if constexpr (FP8) { PG8_SCHED; asm volatile("s_nop 15\n\ts_nop 15" ::: "memory"); PG8_SCHED; }
        E(acc, cur, wr, wc, fr, fq, cbuf + (ui & 1) * 2048);
        if (!has_next) break;
        cur = nxt; cA = nA; cB = nB; ++ui;
        if constexpr (ALIGN_EPI) { if (wr == 1) PG8_BAR; }
    }
    PG8_WAIT_V(0);
    if constexpr (!ALIGN_EPI) { if (wr == 0) PG8_BAR; }
    PG8_BAR;
#undef PG8_SA
#undef PG8_SB
#undef PG8_STAGE
#undef PG8_STAGE_A
#undef PG8_LDA
#undef PG8_LDB
#undef PG8_MMA
#undef PG8_MMA0
#undef PG8_ITER
#undef PG8_LD8
#undef PG8_WAIT_V
#undef PG8_WAIT_L
#undef PG8_BAR
#undef PG8_SCHED
#undef PG8_GLOAD
}

struct EpiInProj {
    static constexpr bool PERM = true, HAS_PF = false; static constexpr int NE = 12;
    bf16* proj; const float* lb;
    __device__ __forceinline__ void operator()(const f32x4 (&acc)[2][2][4][2], const Unit& u, int wr, int wc, int fr, int fq, const LAS unsigned char*) const {
        const int t = u.pn >> 1;
        bf16* base = proj + (size_t)t * PROJ_STRIDE;
        const int row0 = u.pm * BM + wr * 64 + fr, col0 = (u.pn & 1) * 256 + wc * 32 + 8 * fq;
        f32x4 lbv[2][2];
#pragma unroll
        for (int bj = 0; bj < 2; ++bj)
#pragma unroll
            for (int n = 0; n < 2; ++n) lbv[bj][n] = (t == 4) ? *(const f32x4*)(lb + col0 + bj * HALF + 4 * n) : (f32x4){0.f, 0.f, 0.f, 0.f};
#pragma unroll
        for (int ai = 0; ai < 2; ++ai)
#pragma unroll
            for (int m = 0; m < 4; ++m) { bf16* rowp = base + (size_t)(row0 + ai * HALF + m * 16) * 512 + col0;
#pragma unroll
                for (int bj = 0; bj < 2; ++bj) { f32x4 v[2] = {acc[ai][bj][m][0], acc[ai][bj][m][1]};
                    if (t == 0) { v[0] = v[0] * QSCALE; v[1] = v[1] * QSCALE; }
                    else if (t == 3) {
#pragma unroll
                        for (int n = 0; n < 2; ++n)
#pragma unroll
                            for (int j = 0; j < 4; ++j) v[n][j] = siluf_(v[n][j]) * 0.08838834764831845f; }
                    else if (t == 4) {
#pragma unroll
                        for (int n = 0; n < 2; ++n)
#pragma unroll
                            for (int j = 0; j < 4; ++j) { const float l = lbv[bj][n][j]; const float f = l + (1.0f - l) * sigmoidf_(v[n][j]); v[n][j] = __builtin_amdgcn_logf(f) * LN2; } }
                    else if (t == 6) {
#pragma unroll
                        for (int n = 0; n < 2; ++n)
#pragma unroll
                            for (int j = 0; j < 4; ++j) v[n][j] = siluf_(v[n][j]); }
                    u32x4 w; w.x = cvt_pk_bf16(v[0][0], v[0][1]); w.y = cvt_pk_bf16(v[0][2], v[0][3]); w.z = cvt_pk_bf16(v[1][0], v[1][1]); w.w = cvt_pk_bf16(v[1][2], v[1][3]);
                    *(u32x4*)(rowp + bj * HALF) = w; } }
    }
};
struct EpiOutProj {
    static constexpr bool PERM = true, HAS_PF = false; static constexpr int NE = 28;
    const float* x; bf16* hb;
    __device__ __forceinline__ void operator()(const f32x4 (&acc)[2][2][4][2], const Unit& u, int wr, int wc, int fr, int fq, const LAS unsigned char*) const {
        const int row0 = u.pm * BM + wr * 64 + fr, col0 = u.pn * BM + wc * 32 + 8 * fq;
#pragma unroll
        for (int ai = 0; ai < 2; ++ai) {
            f32x4 xv[4][2][2];
#pragma unroll
            for (int m = 0; m < 4; ++m)
#pragma unroll
                for (int bj = 0; bj < 2; ++bj) { const size_t p = (size_t)(row0 + ai * HALF + m * 16) * D + col0 + bj * HALF;
                    xv[m][bj][0] = __builtin_nontemporal_load((const f32x4*)(x + p)); xv[m][bj][1] = __builtin_nontemporal_load((const f32x4*)(x + p + 4)); }
            __builtin_amdgcn_sched_barrier(0);
#pragma unroll
            for (int m = 0; m < 4; ++m)
#pragma unroll
                for (int bj = 0; bj < 2; ++bj) { const size_t p = (size_t)(row0 + ai * HALF + m * 16) * D + col0 + bj * HALF;
                    const f32x4 v0 = xv[m][bj][0] + acc[ai][bj][m][0], v1 = xv[m][bj][1] + acc[ai][bj][m][1];
                    u32x4 w; w.x = cvt_pk_bf16(v0[0], v0[1]); w.y = cvt_pk_bf16(v0[2], v0[3]); w.z = cvt_pk_bf16(v1[0], v1[1]); w.w = cvt_pk_bf16(v1[2], v1[3]);
                    *(u32x4*)(hb + p) = w; }
            __builtin_amdgcn_sched_barrier(0);
        }
    }
};
__device__ __forceinline__ u32x4 widen16(v2u a, v2u b) {
    const auto r0 = __builtin_amdgcn_permlane16_swap(a.x, b.x, false, false), r1 = __builtin_amdgcn_permlane16_swap(a.y, b.y, false, false);
    return (u32x4){r0[0], r1[0], r0[1], r1[1]};
}
struct EpiSwiglu {
    static constexpr bool PERM = true, HAS_PF = true; static constexpr int NE = 4;
    unsigned char* act; const float* bgu; const float* rs;
    __device__ __forceinline__ void prefetch(const Unit& u, LAS unsigned char* cb, int lane) const {
        const float* b0 = bgu + (size_t)u.e * 2048 + u.pn * 128 + (lane < 32 ? lane * 4 : 1024 + (lane - 32) * 4);
        __builtin_amdgcn_global_load_lds((const unsigned*)b0, (LAS unsigned*)cb, 16, 0, 0);
        __builtin_amdgcn_global_load_lds((const unsigned*)(rs + (size_t)u.e * ECAP + u.pm * 256 + lane * 4), (LAS unsigned*)(cb + 1024), 16, 0, 0);
    }
    __device__ __forceinline__ void operator()(const f32x4 (&acc)[2][2][4][2], const Unit& u, int wr, int wc, int fr, int fq, const LAS unsigned char* cb) const {
        const int cl = wc * 32 + 8 * fq, odd = fq & 1, colW = u.pn * 128 + wc * 32 + 8 * (fq & 2);
        f32x4 bgv[2], buv[2];
#pragma unroll
        for (int n = 0; n < 2; ++n) { bgv[n] = *(const LAS f32x4*)(cb + (cl + 4 * n) * 4); buv[n] = *(const LAS f32x4*)(cb + 512 + (cl + 4 * n) * 4); }
        float rs8[2][4];
#pragma unroll
        for (int ai = 0; ai < 2; ++ai)
#pragma unroll
            for (int m = 0; m < 4; ++m) rs8[ai][m] = *(const LAS float*)(cb + 1024 + (ai * HALF + wr * 64 + m * 16 + fr) * 4);
#pragma unroll
        for (int ai = 0; ai < 2; ++ai)
#pragma unroll
            for (int mp = 0; mp < 2; ++mp) { v2u wv[2];
#pragma unroll
                for (int h = 0; h < 2; ++h) { const int m = 2 * mp + h, rl = ai * HALF + wr * 64 + m * 16 + fr; const float rstd = (rl < u.nvalid) ? rs8[ai][m] * (1.0f / (X8S * W8S)) : 0.f;
                    unsigned w[2];
#pragma unroll
                    for (int n = 0; n < 2; ++n) { float o[4];
#pragma unroll
                        for (int j = 0; j < 4; ++j) { float g = acc[ai][0][m][n][j] * rstd + bgv[n][j], up = acc[ai][1][m][n][j] * rstd + buv[n][j];
                            g = fminf(g, 7.0f); up = __builtin_amdgcn_fmed3f(up, -7.0f, 7.0f); o[j] = (g * frcp(1.0f + fexp2(-1.702f * LOG2E * g))) * (up * A8S + A8S); }
                        int w_ = 0; w_ = __builtin_amdgcn_cvt_pk_fp8_f32(o[0], o[1], w_, false); w_ = __builtin_amdgcn_cvt_pk_fp8_f32(o[2], o[3], w_, true); w[n] = (unsigned)w_; }
                    wv[h] = (v2u){w[0], w[1]}; }
                const int rs = ai * HALF + wr * 64 + (2 * mp + odd) * 16 + fr;
                *(u32x4*)(act + (size_t)(u.rowbase + u.pm * 256 + rs) * 1024 + colW) = widen16(wv[0], wv[1]); }
    }
};
struct EpiDown {
    static constexpr bool PERM = true, HAS_PF = true; static constexpr int NE = 8;
    unsigned char* obuf; const float* bdn; const float* gate;
    __device__ __forceinline__ void prefetch(const Unit& u, LAS unsigned char* cb, int lane) const {
        __builtin_amdgcn_global_load_lds((const unsigned*)(bdn + (size_t)u.e * 1024 + u.pn * 256 + lane * 4), (LAS unsigned*)cb, 16, 0, 0);
        __builtin_amdgcn_global_load_lds((const unsigned*)(gate + (size_t)u.e * ECAP + u.pm * 256 + lane * 4), (LAS unsigned*)(cb + 1024), 16, 0, 0);
    }
    __device__ __forceinline__ void operator()(const f32x4 (&acc)[2][2][4][2], const Unit& u, int wr, int wc, int fr, int fq, const LAS unsigned char* cb) const {
        const int cl = wc * 32 + 8 * fq, odd = fq & 1, colW = u.pn * BM + wc * 32 + 8 * (fq & 2);
        f32x4 bv[2][2];
#pragma unroll
        for (int bj = 0; bj < 2; ++bj)
#pragma unroll
            for (int n = 0; n < 2; ++n) bv[bj][n] = *(const LAS f32x4*)(cb + (bj * HALF + cl + 4 * n) * 4);
        float gt8[2][4];
#pragma unroll
        for (int ai = 0; ai < 2; ++ai)
#pragma unroll
            for (int m = 0; m < 4; ++m) gt8[ai][m] = *(const LAS float*)(cb + 1024 + (ai * HALF + wr * 64 + m * 16 + fr) * 4);
#pragma unroll
        for (int ai = 0; ai < 2; ++ai)
#pragma unroll
            for (int mp = 0; mp < 2; ++mp) { v2u wv[2][2];
#pragma unroll
                for (int h = 0; h < 2; ++h) { const int m = 2 * mp + h; const float gt = gt8[ai][m] * O8S;
#pragma unroll
                    for (int bj = 0; bj < 2; ++bj) { const f32x4 v0 = (acc[ai][bj][m][0] * (1.0f / (A8S * W8S)) + bv[bj][0]) * gt, v1 = (acc[ai][bj][m][1] * (1.0f / (A8S * W8S)) + bv[bj][1]) * gt;
                        wv[h][bj] = (v2u){pk4_fp8(v0[0], v0[1], v0[2], v0[3]), pk4_fp8(v1[0], v1[1], v1[2], v1[3])}; } }
                unsigned char* rowp = obuf + (size_t)(u.rowbase + u.pm * 256 + ai * HALF + wr * 64 + (2 * mp + odd) * 16 + fr) * 1024 + colW;
#pragma unroll
                for (int bj = 0; bj < 2; ++bj) *(u32x4*)(rowp + bj * HALF) = widen16(wv[0][bj], wv[1][bj]); }
    }
};
}

#define XB_TMO      128
#define XB_XCNT(j)  (256  + 64 * (j))
#define XB_XSUB(j)  (1280 + 64 * (j))
#define XB_XGEN(j)  (2304 + 64 * (j))
#define XB_TOP      3328
#define XB_TOPGEN   3392
#define XCD_BAR_WORDS 3456
#define XB_SPIN_CAP (1u << 18)
__device__ __forceinline__ unsigned xb_ld(unsigned* p)              { return __hip_atomic_load(p, __ATOMIC_RELAXED, __HIP_MEMORY_SCOPE_AGENT); }
__device__ __forceinline__ unsigned xb_add(unsigned* p, unsigned v) { return __hip_atomic_fetch_add(p, v, __ATOMIC_RELAXED, __HIP_MEMORY_SCOPE_AGENT); }
__device__ __forceinline__ unsigned xb_xcc_id() { return (unsigned)__builtin_amdgcn_s_getreg((3 << 11) | 20) & 0xFu; }
#define XB_SPIN(cond, bar) do { unsigned _sp = 0; while (cond) { __builtin_amdgcn_s_sleep(1); \
    if ((++_sp & 255u) == 0u) { if (xb_ld(&(bar)[XB_TMO])) break; if (_sp > XB_SPIN_CAP) { atomicAdd(&(bar)[XB_TMO], 1u); break; } } } } while (0)
struct XcdBarrier { unsigned* bar; unsigned x; volatile LAS unsigned* st; };
__device__ __forceinline__ XcdBarrier xcd_barrier_post(unsigned* bar, volatile LAS unsigned* st) {
    XcdBarrier b; b.bar = bar; b.x = xb_xcc_id(); b.st = st;
    if (threadIdx.x == 0) (void)xb_add(&bar[XB_XCNT(b.x)], 1u);
    return b;
}
__device__ __forceinline__ void xcd_barrier_complete(unsigned* bar, unsigned x, unsigned& nloc, unsigned& nx) {
    const unsigned G = gridDim.x * gridDim.y * gridDim.z;
    unsigned sum, cnt, mine, sp = 0u;
    for (;;) {
        sum = 0u; cnt = 0u; mine = 0u;
#pragma unroll
        for (unsigned j = 0; j < 16; ++j) { const unsigned c = xb_ld(&bar[XB_XCNT(j)]); sum += c; cnt += (c > 0u) ? 1u : 0u; mine = (j == x) ? c : mine; }
        if (sum == G) break;
        __builtin_amdgcn_s_sleep(1);
        if ((++sp & 255u) == 0u) { if (xb_ld(&bar[XB_TMO])) break; if (sp > XB_SPIN_CAP) { atomicAdd(&bar[XB_TMO], 1u); break; } }
    }
    nloc = mine > 0u ? mine : 1u; nx = cnt > 0u ? cnt : 1u;
}
__device__ __forceinline__ void xcd_barrier(const XcdBarrier& b) {
    asm volatile("s_waitcnt vmcnt(0)" ::: "memory");
    __syncthreads();
    if (threadIdx.x == 0) {
        unsigned* bar = b.bar;
        __builtin_amdgcn_s_waitcnt(0);
        unsigned nloc = b.st[0], nx = b.st[1];
        if (nloc == 0u) { xcd_barrier_complete(bar, b.x, nloc, nx); b.st[0] = nloc; b.st[1] = nx; }
        const unsigned old = xb_add(&bar[XB_XSUB(b.x)], 1u);
        const unsigned gen = old / nloc;
        if (old + 1u == (gen + 1u) * nloc) {
            __builtin_amdgcn_fence(__ATOMIC_RELEASE, "agent");
            asm volatile("s_waitcnt vmcnt(0)" ::: "memory");
            const unsigned og = xb_add(&bar[XB_TOP], 1u);
            const unsigned tg = og / nx;
            if (og + 1u == (tg + 1u) * nx) xb_add(&bar[XB_TOPGEN], 1u);
            else XB_SPIN(xb_ld(&bar[XB_TOPGEN]) == tg, bar);
            __builtin_amdgcn_fence(__ATOMIC_ACQUIRE, "agent");
            xb_add(&bar[XB_XGEN(b.x)], 1u);
            asm volatile("s_waitcnt vmcnt(0)" ::: "memory");
        } else {
            XB_SPIN(xb_ld(&bar[XB_XGEN(b.x)]) == gen, bar);
            __builtin_amdgcn_fence(__ATOMIC_ACQUIRE, "agent");
            asm volatile("s_waitcnt vmcnt(0)" ::: "memory");
        }
    }
    __syncthreads();
}

struct Args { const float* in[15]; float* out; unsigned char* ws; int ph_lo, ph_hi; unsigned char bkt[3][136]; };
struct Frame {
    LAS unsigned char* lds; volatile LAS unsigned* MISC; gu32* ctl;
    int tid, lane, wave, vcu, G;
    unsigned char* ws;
};
__device__ __forceinline__ float wave_sum(float v) {
#pragma unroll
    for (int o = 1; o < 64; o <<= 1) v += __shfl_xor(v, o);
    return v;
}
__device__ __forceinline__ float wave_max(float v) {
#pragma unroll
    for (int o = 1; o < 64; o <<= 1) v = fmaxf(v, __shfl_xor(v, o));
    return v;
}

__device__ __forceinline__ void p0_transpose_item(const float* W, int K, int N, bf16* WT, int kb, int nb, int dst_row0, LAS float* scr, int lane) {
    const int k0 = 64 * kb, n0 = 32 * nb;
    float wv_[32];
#pragma unroll
    for (int i = 0; i < 32; ++i) wv_[i] = __builtin_nontemporal_load(W + (size_t)(k0 + 2 * i + (lane >> 5)) * N + n0 + (lane & 31));
#pragma unroll
    for (int i = 0; i < 32; ++i) scr[(2 * i + (lane >> 5)) * 33 + (lane & 31)] = wv_[i];
    LDS_WAIT(); asm volatile("" ::: "memory");
    const int c = lane & 7;
#pragma unroll
    for (int j = 0; j < 4; ++j) { const int n = (lane >> 3) + 8 * j; const LAS float* s = scr + (8 * c) * 33 + n;
        v4u o; o.x = pk2(s[0 * 33], s[1 * 33]); o.y = pk2(s[2 * 33], s[3 * 33]); o.z = pk2(s[4 * 33], s[5 * 33]); o.w = pk2(s[6 * 33], s[7 * 33]);
        *(GAS v4u*)(WT + (size_t)(dst_row0 + n) * K + k0 + 8 * c) = o; }
    LDS_WAIT(); asm volatile("" ::: "memory");
}
__device__ __forceinline__ void p0_transpose_item_fp8(const float* W, int K, int N, unsigned char* WT, int kb, int nb, int dst_row0, LAS float* scr, int lane) {
    const int k0 = 64 * kb, n0 = 32 * nb;
    float wv_[32];
#pragma unroll
    for (int i = 0; i < 32; ++i) wv_[i] = __builtin_nontemporal_load(W + (size_t)(k0 + 2 * i + (lane >> 5)) * N + n0 + (lane & 31));
#pragma unroll
    for (int i = 0; i < 32; ++i) scr[(2 * i + (lane >> 5)) * 33 + (lane & 31)] = wv_[i];
    LDS_WAIT(); asm volatile("" ::: "memory");
    const int c = lane & 7;
#pragma unroll
    for (int j = 0; j < 4; ++j) { const int n = (lane >> 3) + 8 * j; const LAS float* sp = scr + (8 * c) * 33 + n;
        v2u o; o.x = pk4_fp8(sp[0 * 33] * W8S, sp[1 * 33] * W8S, sp[2 * 33] * W8S, sp[3 * 33] * W8S); o.y = pk4_fp8(sp[4 * 33] * W8S, sp[5 * 33] * W8S, sp[6 * 33] * W8S, sp[7 * 33] * W8S);
        *(GAS v2u*)(WT + (size_t)(dst_row0 + n) * K + k0 + 8 * c) = o; }
    LDS_WAIT(); asm volatile("" ::: "memory");
}
__device__ __forceinline__ void p0_prologue(Frame& F, const Args& a) {
    LAS float* scr = (LAS float*)(F.lds + F.wave * 16384);
    const int gw = F.vcu * NWAVES + F.wave, NGW = F.G * NWAVES;
    const float* w_in = a.in[2]; const float* w_out = a.in[6];
    bf16* WIN = (bf16*)(F.ws + WS_WIN); bf16* WOUT = (bf16*)(F.ws + WS_WOUT);
    constexpr int I_IN = 16 * 112, I_OUT = 16 * 32;
    constexpr int NITEMS = I_IN + I_OUT;
    for (int it = gw; it < NITEMS; it += NGW) {
        int r = it;
        if (r < I_IN) { p0_transpose_item(w_in, D, NPROJ, WIN, r / 112, r % 112, 32 * (r % 112), scr, F.lane); continue; } r -= I_IN;
        p0_transpose_item(w_out, D, D, WOUT, r / 32, r % 32, 32 * (r % 32), scr, F.lane);
    }
    { const int gt = (F.vcu * NWAVES + F.wave) * 64 + F.lane, NT = F.G * NWAVES * 64;
        const float* rw = a.in[8]; const float* nf = a.in[7]; bf16* WR = (bf16*)(F.ws + WS_WR);
        for (int idx = gt; idx < D * NE; idx += NT) { const int k = idx >> 5, e = idx & 31; const float v = rw[idx] * nf[k]; const unsigned hi = f2bf(v); const unsigned lo = f2bf(v - bf2f(hi));
            WR[(size_t)e * 1024 + k] = (bf16)hi; WR[(size_t)(32 + e) * 1024 + k] = (bf16)lo; }
        const float* lbl = a.in[4]; float* LB = (float*)(F.ws + WS_LB);
        for (int c = gt; c < 512; c += NT) LB[c] = frcp(1.0f + __expf(lbl[512 + c] - lbl[c]));
    }
    { const float* x = a.in[0]; const float* nw = a.in[1]; bf16* XN = (bf16*)(F.ws + WS_XN);
        f32x4 wv[4];
#pragma unroll
        for (int j = 0; j < 4; ++j) wv[j] = *((const f32x4*)nw + F.lane + 64 * j);
        for (int m = gw; m < M; m += NGW) {
            const GAS f32x4* xr = (const GAS f32x4*)(x + (size_t)m * D) + F.lane;
            f32x4 v[4]; float s = 0.f;
#pragma unroll
            for (int j = 0; j < 4; ++j) { v[j] = __builtin_nontemporal_load(xr + 64 * j); s += (v[j].x * v[j].x + v[j].y * v[j].y) + (v[j].z * v[j].z + v[j].w * v[j].w); }
            const float rstd = 1.0f / sqrtf(wave_sum(s) * (1.f / D) + RMS_EPS);
            GAS unsigned long long* o8 = (GAS unsigned long long*)(XN + (size_t)m * D) + F.lane;
#pragma unroll
            for (int j = 0; j < 4; ++j) { const f32x4 y = v[j] * rstd * wv[j]; o8[64 * j] = (unsigned long long)pk2(y.x, y.y) | ((unsigned long long)pk2(y.z, y.w) << 32); }
        }
    }
}

typedef float f32x16 __attribute__((ext_vector_type(16)));
typedef short s16x4 __attribute__((ext_vector_type(4)));
typedef short v4i16_t __attribute__((ext_vector_type(4)));
__device__ __forceinline__ s16x4 ds_tr16(const LAS unsigned char* p) { return __builtin_bit_cast(s16x4, __builtin_amdgcn_ds_read_tr16_b64_v4i16((LAS v4i16_t*)p)); }
__device__ __forceinline__ float xhalf_max(float v) { auto rr = __builtin_amdgcn_permlane32_swap(__float_as_uint(v), __float_as_uint(v), false, false); return fmaxf(__uint_as_float(rr[0]), __uint_as_float(rr[1])); }
__device__ __forceinline__ float xhalf_sum(float v) { auto rr = __builtin_amdgcn_permlane32_swap(__float_as_uint(v), __float_as_uint(v), false, false); return __uint_as_float(rr[0]) + __uint_as_float(rr[1]); }
__device__ __forceinline__ void attn_task2(const bf16* QA, const bf16* KA, const bf16* VA, bf16* RUN, float* LRUN, bf16* MIX, const int mode, const LAS float* tbl, LAS unsigned char* vt,
                                           const int b, const int h, const int dil, const int pos0, const int lane) {
    const int q = lane & 31, hi = lane >> 5;
    const size_t rowb = (size_t)b * SEQ;
    bf16x8 qr[2][4];
    const bf16* Qb = QA + rowb * 512 + h * 64; const bf16* Kb = KA + rowb * 512 + h * 64; const bf16* Vb = VA + rowb * 512 + h * 64;
#pragma unroll
    for (int t = 0; t < 2; ++t) { const unsigned qo = (unsigned)((pos0 + dil * (32 * t + q)) * 512 + 8 * hi);
#pragma unroll
        for (int d0 = 0; d0 < 4; ++d0) qr[t][d0] = *(const bf16x8*)(Qb + qo + 16 * d0); }
    int c0 = 0; while (pos0 + dil * (32 * c0 - 128) < 0) ++c0;
    float m[2] = {-1e30f, -1e30f}, l[2] = {0.f, 0.f}; f32x16 o0[2], o1[2];
#pragma unroll
    for (int t = 0; t < 2; ++t)
#pragma unroll
        for (int r = 0; r < 16; ++r) { o0[t][r] = 0.f; o1[t][r] = 0.f; }
    const int trrow = (lane & 15) >> 2, trcol = 16 * ((lane >> 4) & 1) + 4 * (lane & 3);
    v4u kr[4], vn[4]; bf16x8 kf[4];
    LAS unsigned char* kt = vt + 5120;
    const unsigned ro0 = (unsigned)(dil * (lane >> 3) * 512 + 8 * (lane & 7));
#define ATT_TBASE(cc, i_) ((pos0 + dil * (32 * ((cc) < c0 ? c0 : (cc)) - 128 + 8 * (i_))) * 512)
#define ATT_LOADK(cc) do { _Pragma("unroll") for (int i = 0; i < 4; ++i) kr[i] = *(const v4u*)(Kb + ATT_TBASE(cc, i) + ro0); } while (0)
#define ATT_LOADV(cc) do { _Pragma("unroll") for (int i = 0; i < 4; ++i) vn[i] = *(const v4u*)(Vb + ATT_TBASE(cc, i) + ro0); } while (0)
    ATT_LOADK(0);
#pragma unroll
    for (int c = 0; c < 6; ++c) {
        ATT_LOADV(c);
#pragma unroll
        for (int i = 0; i < 4; ++i) { const int id = lane + 64 * i; *(LAS v4u*)(kt + (id >> 3) * 144 + (id & 7) * 16) = kr[i]; }
        if (c + 1 < 6) ATT_LOADK(c + 1);
#pragma unroll
        for (int d0 = 0; d0 < 4; ++d0) kf[d0] = *(const LAS bf16x8*)(kt + q * 144 + (16 * d0 + 8 * hi) * 2);
        if (c >= c0) {
        bool staged = false;
#pragma unroll
        for (int t = 0; t < 2; ++t) { const int ct = c - t;
            if (ct >= 0 && ct <= 4) {
                f32x16 s;
#pragma unroll
                for (int g4 = 0; g4 < 4; ++g4) { const f32x4 bq = *(const LAS f32x4*)(tbl + ((ct * 4 + g4) * 64 + lane) * 4); s[4 * g4] = bq.x; s[4 * g4 + 1] = bq.y; s[4 * g4 + 2] = bq.z; s[4 * g4 + 3] = bq.w; }
#pragma unroll
                for (int d0 = 0; d0 < 4; ++d0) s = __builtin_amdgcn_mfma_f32_32x32x16_bf16(kf[d0], qr[t][d0], s, 0, 0, 0);
                float mx = -1e30f;
#pragma unroll
                for (int r = 0; r < 16; ++r) mx = fmaxf(mx, s[r]);
                mx = xhalf_max(mx);
                if (__any(mx > m[t] + 8.0f)) {
                    const float mn = fmaxf(m[t], mx), alpha = fexp2(m[t] - mn); m[t] = mn; l[t] *= alpha;
#pragma unroll
                    for (int r = 0; r < 16; ++r) { o0[t][r] *= alpha; o1[t][r] *= alpha; } }
                const float mref = m[t];
                float ps = 0.f;
#pragma unroll
                for (int r = 0; r < 16; ++r) { s[r] = fexp2(s[r] - mref); ps += s[r]; }
                l[t] += ps;
                if (!staged) { staged = true;
#pragma unroll
                    for (int i = 0; i < 4; ++i) { const int id = lane + 64 * i; *(LAS v4u*)(vt + (id >> 3) * 128 + (id & 7) * 16) = vn[i]; }
                }
#pragma unroll
                for (int ks = 0; ks < 2; ++ks) {
                    v4u pw; pw.x = pg8::cvt_pk_bf16(s[8 * ks], s[8 * ks + 1]); pw.y = pg8::cvt_pk_bf16(s[8 * ks + 2], s[8 * ks + 3]); pw.z = pg8::cvt_pk_bf16(s[8 * ks + 4], s[8 * ks + 5]); pw.w = pg8::cvt_pk_bf16(s[8 * ks + 6], s[8 * ks + 7]);
                    const bf16x8 pf = __builtin_bit_cast(bf16x8, pw);
                    const LAS unsigned char* va = vt + (16 * ks + 4 * hi + trrow) * 128 + trcol * 2;
                    s16x4 l0 = ds_tr16(va), h0 = ds_tr16(va + 8 * 128), l1 = ds_tr16(va + 64), h1 = ds_tr16(va + 64 + 8 * 128);
                    asm volatile("s_waitcnt lgkmcnt(0)" : "+v"(l0), "+v"(h0), "+v"(l1), "+v"(h1) :: "memory");
                    o0[t] = __builtin_amdgcn_mfma_f32_32x32x16_bf16((bf16x8){l0[0], l0[1], l0[2], l0[3], h0[0], h0[1], h0[2], h0[3]}, pf, o0[t], 0, 0, 0);
                    o1[t] = __builtin_amdgcn_mfma_f32_32x32x16_bf16((bf16x8){l1[0], l1[1], l1[2], l1[3], h1[0], h1[1], h1[2], h1[3]}, pf, o1[t], 0, 0, 0);
                }
            } }
        }
    }
#undef ATT_LOADK
#undef ATT_LOADV
#undef ATT_TBASE
    bf16* RUNb = RUN + rowb * 512 + h * 64; float* LRUNb = LRUN + rowb * 8 + h; bf16* MIXb = MIX + rowb * 1024 + h * 64;
#pragma unroll
    for (int t = 0; t < 2; ++t) {
        const float lt = xhalf_sum(l[t]); const float inv = frcp(lt);
#pragma unroll
        for (int g = 0; g < 4; ++g) {
            v2u w0, w1;
            w0.x = pg8::cvt_pk_bf16(o0[t][4 * g] * inv, o0[t][4 * g + 1] * inv); w0.y = pg8::cvt_pk_bf16(o0[t][4 * g + 2] * inv, o0[t][4 * g + 3] * inv);
            w1.x = pg8::cvt_pk_bf16(o1[t][4 * g] * inv, o1[t][4 * g + 1] * inv); w1.y = pg8::cvt_pk_bf16(o1[t][4 * g + 2] * inv, o1[t][4 * g + 3] * inv);
            *(LAS v2u*)(vt + q * 144 + (8 * g + 4 * hi) * 2) = w0; *(LAS v2u*)(vt + q * 144 + (32 + 8 * g + 4 * hi) * 2) = w1;
        }
        if (hi == 0) *(LAS float*)(vt + 4608 + q * 4) = m[t] + __builtin_amdgcn_logf(lt);
        v4u rv[4]; float rl[4];
        if (mode > 0) {
#pragma unroll
            for (int i = 0; i < 4; ++i) { const int row = 8 * i + (lane >> 3), ch = lane & 7; const unsigned ro = (unsigned)(pos0 + dil * (32 * t + row));
                rv[i] = *(const v4u*)(RUNb + (unsigned)(ro * 512 + 8 * ch)); rl[i] = LRUNb[(unsigned)(ro * 8)]; } }
        asm volatile("s_waitcnt lgkmcnt(0)" ::: "memory");
#pragma unroll
        for (int i = 0; i < 4; ++i) { const int row = 8 * i + (lane >> 3), ch = lane & 7; const unsigned ro = (unsigned)(pos0 + dil * (32 * t + row));
            v4u v = *(const LAS v4u*)(vt + row * 144 + ch * 16); float ln = *(const LAS float*)(vt + 4608 + row * 4);
            if (mode > 0) { const float mx = fmaxf(ln, rl[i]), wn0 = fexp2(ln - mx), wr0 = fexp2(rl[i] - mx), sw = wn0 + wr0, iv = frcp(sw), wn = wn0 * iv, wr = wr0 * iv; const v4u r = rv[i];
                v.x = pk2(wn * bflo(v.x) + wr * bflo(r.x), wn * bfhi(v.x) + wr * bfhi(r.x)); v.y = pk2(wn * bflo(v.y) + wr * bflo(r.y), wn * bfhi(v.y) + wr * bfhi(r.y));
                v.z = pk2(wn * bflo(v.z) + wr * bflo(r.z), wn * bfhi(v.z) + wr * bfhi(r.z)); v.w = pk2(wn * bflo(v.w) + wr * bflo(r.w), wn * bfhi(v.w) + wr * bfhi(r.w));
                ln = mx + __builtin_amdgcn_logf(sw); }
            if (mode < 2) { *(v4u*)(RUNb + (unsigned)(ro * 512 + 8 * ch)) = v; if (ch == 0) LRUNb[(unsigned)(ro * 8)] = ln; }
            else *(v4u*)(MIXb + (unsigned)(ro * 1024 + 8 * ch)) = v; }
        asm volatile("s_waitcnt lgkmcnt(0)" ::: "memory");
    }
}
__device__ __forceinline__ void attn_mfma(Frame& F, const Args& a, const int rank, const int nblk) {
    LAS float* tbl = (LAS float*)F.lds;
    LAS float* xtb = (LAS float*)(F.lds + 4096 + NWAVES * 9728);
    LAS unsigned char* vt = F.lds + 4096 + F.wave * 9728;
    const float* rel = a.in[3];
    const bf16* QA = (const bf16*)(F.ws + WS_PROJ); const bf16* KA = QA + PROJ_STRIDE; const bf16* VA = QA + 2 * PROJ_STRIDE;
    bf16* ATTP = (bf16*)(F.ws + WS_ATTP); float* LSE = (float*)(F.ws + WS_LSE); bf16* MIX = (bf16*)(F.ws + WS_MIX);
    for (int u = rank; u < 256; u += nblk) {
        const int bh = u >> 2, span = u & 3, b = bh >> 3, h = bh & 7, P0 = span * 1024;
        for (int idx = F.tid; idx < 3 * 192; idx += NWAVES * 64) { const int p = idx / 192, jj = idx % 192 - 32;
            tbl[idx] = (jj >= 0 && jj <= 128) ? rel[(int)a.bkt[p][jj] * 8 + h] * LOG2E : -1e30f; }
        __syncthreads();
        for (int idx = F.tid; idx < 3 * 5 * 4 * 64; idx += NWAVES * 64) { const int ln = idx & 63, g4 = (idx >> 6) & 3, ct = (idx >> 8) % 5, p = idx / 1280, q_ = ln & 31, hi_ = ln >> 5;
            f32x4 v;
#pragma unroll
            for (int e = 0; e < 4; ++e) { const int r = 4 * g4 + e, kv = (r & 3) + 8 * (r >> 2) + 4 * hi_; v[e] = tbl[p * 192 + 160 - 32 * ct + q_ - kv]; }
            *(LAS f32x4*)(xtb + (size_t)idx * 4) = v; }
        __syncthreads();
#pragma unroll 1
        for (int p = 0; p < 3; ++p) {
            const int dil = (p == 0) ? 1 : (p == 1 ? 4 : 16), ppr = 16 / dil;
            for (int kk = 0; kk < 2; ++kk) { const int ix = (F.wave + 8 * kk) , r = ix / ppr, j = ix % ppr;
                attn_task2(QA, KA, VA, ATTP, LSE, MIX, p, xtb + p * 5120, vt, b, h, dil, P0 + r + dil * 64 * j, F.lane); }
            VM_WAIT();
            __syncthreads();
        }
    }
}

constexpr int HPB = 272;
constexpr int H_QE = 0, H_KD = H_QE + 64 * HPB, H_KS = H_KD + 64 * HPB, H_I = H_KS + 64 * HPB, H_QJ = H_I + 64 * HPB, H_AB = H_QJ + 160 * HPB, H_TQ = H_AB + 64 * 144, H_EL = H_TQ + 8192;
constexpr int H_O = RING_BYTES;
static_assert(H_EL + 512 <= RING_BYTES && H_O + 64 * HPB <= TAB_OFF, "hgrn LDS map");
constexpr size_t WS_US = WS_HO, WS_DV = WS_HO + 32 * MiB;
__device__ __forceinline__ f32x4 exp4(f32x4 x) { return (f32x4){fexp2(x.x * LOG2E), fexp2(x.y * LOG2E), fexp2(x.z * LOG2E), fexp2(x.w * LOG2E)}; }
__device__ __forceinline__ v2u pack4(f32x4 v) { v2u r; r.x = pg8::cvt_pk_bf16(v.x, v.y); r.y = pg8::cvt_pk_bf16(v.z, v.w); return r; }
__device__ __forceinline__ f32x4 unpack4(v2u w) { return (f32x4){bflo(w.x), bfhi(w.x), bflo(w.y), bfhi(w.y)}; }
constexpr int G_T0 = 0, G_TSZ = 3 * 64 * HPB, G_TQ = 2 * G_TSZ, G_ET = G_TQ + 2 * 8192, G_END = G_ET + 2 * 2048;
static_assert(G_END <= RING_BYTES, "hgrn2 LDS map");
constexpr int H_NSC = 8, H_CPS = SEQ / 64 / H_NSC;
template <int MODE>
__device__ __forceinline__ void hgrn_units2(Frame& F, const Args& a, const int rank, const int nblk) {
    const bf16* QH = (const bf16*)(F.ws + WS_PROJ) + 3 * PROJ_STRIDE; const bf16* FA = QH + PROJ_STRIDE; const bf16* IH = QH + 2 * PROJ_STRIDE; const bf16* GH = QH + 3 * PROJ_STRIDE;
    float* US = (float*)(F.ws + WS_US); float* DV = (float*)(F.ws + WS_DV); bf16* MIX = (bf16*)(F.ws + WS_MIX);
    LAS unsigned char* L = F.lds;
    const int tid = F.tid, lane = F.lane, w = F.wave, l16 = lane & 15, g = lane >> 4;
    const int kq = tid & 31, tq = tid >> 5, I = tq >> 2;
    for (int u = rank; u < BATCH * HH * H_NSC; u += nblk) {
        const int bh = u & 31, sc = u >> 5, b = bh >> 2, h = bh & 3, unit = bh * H_NSC + sc;
        f32x4 S[8];
        if (MODE == 1) {
#pragma unroll
            for (int kt = 0; kt < 8; ++kt) S[kt] = *(const f32x4*)(US + (size_t)unit * 16384 + w * 2048 + kt * 256 + lane * 4);
        } else {
#pragma unroll
            for (int kt = 0; kt < 8; ++kt) S[kt] = (f32x4){0.f, 0.f, 0.f, 0.f};
        }
        f32x4 sumlast = {0.f, 0.f, 0.f, 0.f};
        const size_t base = ((size_t)b * SEQ + 64 * H_CPS * sc) * 512 + h * 128;
        v2u na[4], nq[4], ni[4];
        f32x4 loc[4], kkv[4], qv[4]; v2u ri[4];
#define G_LOAD(cc) do { _Pragma("unroll") for (int j = 0; j < 4; ++j) { const size_t off_ = base + (size_t)(64 * (cc) + 4 * tq + j) * 512 + 4 * kq; \
            na[j] = __builtin_nontemporal_load((const v2u*)(FA + off_)); if (MODE == 1) nq[j] = __builtin_nontemporal_load((const v2u*)(QH + off_)); ni[j] = __builtin_nontemporal_load((const v2u*)(IH + off_)); } } while (0)
#define G_STAGE_A(buf) do { f32x4 av_[4]; _Pragma("unroll") for (int j = 0; j < 4; ++j) { av_[j] = unpack4(na[j]); if (MODE == 1) qv[j] = unpack4(nq[j]); ri[j] = ni[j]; \
                kkv[j] = (f32x4){1.f, 1.f, 1.f, 1.f} - exp4(av_[j]); } \
            loc[0] = av_[0]; loc[1] = loc[0] + av_[1]; loc[2] = loc[1] + av_[2]; loc[3] = loc[2] + av_[3]; \
            *(LAS f32x4*)(L + G_TQ + (buf) * 8192 + (tq * 128 + 4 * kq) * 4) = loc[3]; } while (0)
#define G_STAGE_B(buf) do { LAS unsigned char* T_ = L + (buf) * G_TSZ; const LAS unsigned char* Q_ = L + G_TQ + (buf) * 8192; \
            f32x4 mypre = {0.f, 0.f, 0.f, 0.f}, tot = mypre; \
            _Pragma("unroll") for (int i = 0; i < 4; ++i) { const f32x4 x_ = *(const LAS f32x4*)(Q_ + ((4 * I + i) * 128 + 4 * kq) * 4); mypre = ((4 * I + i) < tq) ? mypre + x_ : mypre; tot += x_; } \
            if ((tq & 3) == 0) *(LAS f32x4*)(L + G_ET + (buf) * 2048 + (I * 128 + 4 * kq) * 4) = exp4(tot); \
            if (MODE == 0 && tq == 0) { _Pragma("unroll") for (int i = 0; i < 16; ++i) sumlast += *(const LAS f32x4*)(Q_ + (i * 128 + 4 * kq) * 4); } \
            _Pragma("unroll") for (int j = 0; j < 4; ++j) { const int t_ = 4 * tq + j; const f32x4 E_ = exp4(mypre + loc[j]); \
                f32x4 R_; R_.x = fminf(frcp(E_.x), 5.0e34f); R_.y = fminf(frcp(E_.y), 5.0e34f); R_.z = fminf(frcp(E_.z), 5.0e34f); R_.w = fminf(frcp(E_.w), 5.0e34f); \
                if (MODE == 1) *(LAS v2u*)(T_ + t_ * HPB + 8 * kq) = pack4(qv[j] * E_); \
                *(LAS v2u*)(T_ + 64 * HPB + t_ * HPB + 8 * kq) = pack4(kkv[j] * R_); \
                *(LAS v2u*)(T_ + 128 * HPB + t_ * HPB + 8 * kq) = ri[j]; } } while (0)
        G_LOAD(0); G_STAGE_A(0); G_LOAD(1);
        __syncthreads();
        G_STAGE_B(0); G_STAGE_A(1);
        __syncthreads();
        for (int c = 0; c < H_CPS; ++c) {
            if (c + 2 < H_CPS) G_LOAD(c + 2);
            if (c + 1 < H_CPS) G_STAGE_B((c + 1) & 1);
            { const LAS unsigned char* T = L + (c & 1) * G_TSZ; const LAS unsigned char* TK = T + 64 * HPB; const LAS unsigned char* TI = T + 128 * HPB; const LAS unsigned char* ET = L + G_ET + (c & 1) * 2048;
#pragma unroll
              for (int I2 = 0; I2 < 4; ++I2) { const int r0 = 16 * I2;
                s16x4 ib = ds_tr16(TI + (r0 + 4 * g + (l16 >> 2)) * HPB + (16 * w + 4 * (l16 & 3)) * 2);
                s16x4 kk_[8];
#pragma unroll
                for (int kt = 0; kt < 8; ++kt) kk_[kt] = ds_tr16(TK + (r0 + 4 * g + (l16 >> 2)) * HPB + (16 * kt + 4 * (l16 & 3)) * 2);
                asm volatile("s_waitcnt lgkmcnt(0)" : "+v"(ib), "+v"(kk_[0]), "+v"(kk_[1]), "+v"(kk_[2]), "+v"(kk_[3]), "+v"(kk_[4]), "+v"(kk_[5]), "+v"(kk_[6]), "+v"(kk_[7]) :: "memory");
                const bf16x8 IB = (bf16x8){ib[0], ib[1], ib[2], ib[3], 0, 0, 0, 0};
                if (MODE == 1) {
                    f32x4 o = {0.f, 0.f, 0.f, 0.f}, AT = {0.f, 0.f, 0.f, 0.f};
#pragma unroll
                    for (int k4 = 0; k4 < 4; ++k4) {
                        const LAS unsigned char* qp = T + (r0 + l16) * HPB + (32 * k4 + 4 * g) * 2; const LAS unsigned char* kp = TK + (r0 + l16) * HPB + (32 * k4 + 4 * g) * 2;
                        const v2u ql = *(const LAS v2u*)qp, qh = *(const LAS v2u*)(qp + 32), kl = *(const LAS v2u*)kp, kh = *(const LAS v2u*)(kp + 32);
                        const bf16x8 Aq = __builtin_bit_cast(bf16x8, (v4u){ql.x, ql.y, qh.x, qh.y}), Kr = __builtin_bit_cast(bf16x8, (v4u){kl.x, kl.y, kh.x, kh.y});
                        v4u sw; { const v2u lo = pack4(S[2 * k4]), hh = pack4(S[2 * k4 + 1]); sw.x = lo.x; sw.y = lo.y; sw.z = hh.x; sw.w = hh.y; }
                        o = __builtin_amdgcn_mfma_f32_16x16x32_bf16(Aq, __builtin_bit_cast(bf16x8, sw), o, 0, 0, 0);
                        AT = __builtin_amdgcn_mfma_f32_16x16x32_bf16(Kr, Aq, AT, 0, 0, 0); }
#pragma unroll
                    for (int j = 0; j < 4; ++j) AT[j] = (4 * g + j <= l16) ? AT[j] : 0.f;
                    const v2u ap = pack4(AT);
                    o = __builtin_amdgcn_mfma_f32_16x16x32_bf16(__builtin_bit_cast(bf16x8, (v4u){ap.x, ap.y, 0u, 0u}), IB, o, 0, 0, 0);
#pragma unroll
                    for (int j = 0; j < 4; ++j) *(LAS bf16*)(L + H_O + (r0 + 4 * g + j) * HPB + (16 * w + l16) * 2) = (bf16)f2bf(o[j]);
                }
#pragma unroll
                for (int kt = 0; kt < 8; ++kt) {
                    S[kt] = __builtin_amdgcn_mfma_f32_16x16x32_bf16((bf16x8){kk_[kt][0], kk_[kt][1], kk_[kt][2], kk_[kt][3], 0, 0, 0, 0}, IB, S[kt], 0, 0, 0);
                    S[kt] = S[kt] * *(const LAS f32x4*)(ET + (I2 * 128 + 16 * kt + 4 * g) * 4); }
              } }
            if (c + 2 < H_CPS) G_STAGE_A(c & 1);
            __syncthreads();
            if (MODE == 1) {
                const float* nw = a.in[5];
#pragma unroll
                for (int it = 0; it < 2; ++it) { const int item = tid + 512 * it, t = item >> 4, v8 = (item & 15) * 8;
                    const v4u ow = *(const LAS v4u*)(L + H_O + t * HPB + v8 * 2);
                    const f32x4 o0 = {bflo(ow.x), bfhi(ow.x), bflo(ow.y), bfhi(ow.y)}, o1 = {bflo(ow.z), bfhi(ow.z), bflo(ow.w), bfhi(ow.w)};
                    float ss = (o0.x * o0.x + o0.y * o0.y) + (o0.z * o0.z + o0.w * o0.w) + (o1.x * o1.x + o1.y * o1.y) + (o1.z * o1.z + o1.w * o1.w);
                    ss += __shfl_xor(ss, 1); ss += __shfl_xor(ss, 2); ss += __shfl_xor(ss, 4); ss += __shfl_xor(ss, 8);
                    const float rstd = 1.0f / sqrtf(ss * (1.f / 128.f) + RMS_EPS);
                    const size_t row = (size_t)b * SEQ + 64 * H_CPS * sc + 64 * c + t;
                    const v4u gw = __builtin_nontemporal_load((const v4u*)(GH + row * 512 + h * 128 + v8));
                    const f32x4 w0 = *(const f32x4*)(nw + v8), w1 = *(const f32x4*)(nw + v8 + 4);
                    const f32x4 y0 = o0 * rstd * w0, y1 = o1 * rstd * w1;
                    v4u o; o.x = pk2(y0.x * bflo(gw.x), y0.y * bfhi(gw.x)); o.y = pk2(y0.z * bflo(gw.y), y0.w * bfhi(gw.y)); o.z = pk2(y1.x * bflo(gw.z), y1.y * bfhi(gw.z)); o.w = pk2(y1.z * bflo(gw.w), y1.w * bfhi(gw.w));
                    *(v4u*)(MIX + row * 1024 + 512 + h * 128 + v8) = o; }
                __syncthreads();
            }
        }
#undef G_LOAD
#undef G_STAGE_A
#undef G_STAGE_B
        if (MODE == 0) {
#pragma unroll
            for (int kt = 0; kt < 8; ++kt) *(f32x4*)(US + (size_t)unit * 16384 + w * 2048 + kt * 256 + lane * 4) = S[kt];
            if (tq == 0) *(f32x4*)(DV + (size_t)unit * 128 + 4 * kq) = exp4(sumlast);
        }
        __syncthreads();
    }
}

__device__ __forceinline__ void hgrn_scan(Frame& F) {
    float* US = (float*)(F.ws + WS_US); const float* DV = (const float*)(F.ws + WS_DV);
    const int gt = (F.vcu * NWAVES + F.wave) * 64 + F.lane, NT = F.G * NWAVES * 64;
    for (int idx = gt; idx < 32 * 4096; idx += NT) { const int bh = idx >> 12, r = idx & 4095, kt = (r & 511) >> 6, ln = r & 63, kb = 16 * kt + 4 * (ln >> 4);
        f32x4 run = {0.f, 0.f, 0.f, 0.f};
#pragma unroll 4
        for (int sc = 0; sc < H_NSC; ++sc) { const size_t unit = (size_t)bh * H_NSC + sc; float* p = US + unit * 16384 + (size_t)r * 4;
            const f32x4 uu = __builtin_nontemporal_load((const f32x4*)p), d = *(const f32x4*)(DV + unit * 128 + kb);
            *(f32x4*)p = run; run = d * run + uu; }
    }
}

constexpr int CV_GU = NE * 16 * 64, CV_DN = NE * 16 * 32;
__device__ __forceinline__ int dn_early(const int G) { const int n = 64 * G; return n < CV_DN ? n : CV_DN; }
__device__ __forceinline__ void moe_dn_item_fp8(Frame& F, const Args& a, const int it, LAS float* scr) {
    const int e = it / (16 * 32), q = it % (16 * 32);
    p0_transpose_item_fp8(a.in[12] + (size_t)e * 1024 * 1024, D, D, F.ws + WS_WDN + (size_t)e * 1024 * 1024, q / 32, q % 32, 32 * (q % 32), scr, F.lane);
}
#define CV_LOAD(w, it_) do { const int e_ = (it_) / 512, q_ = (it_) % 512; const float* s_ = a.in[12] + (size_t)e_ * 1024 * 1024 + (size_t)(64 * (q_ / 32) + (lane >> 5)) * 1024 + 32 * (q_ % 32) + (lane & 31); \
        _Pragma("unroll") for (int i = 0; i < 32; ++i) w[i] = __builtin_nontemporal_load(s_ + (size_t)(2 * i) * 1024); } while (0)
#define CV_FINISH(w, it_) do { const int e_ = (it_) / 512, q_ = (it_) % 512; unsigned char* d_ = F.ws + WS_WDN + (size_t)e_ * 1024 * 1024 + (size_t)(32 * (q_ % 32)) * 1024 + 64 * (q_ / 32); \
        _Pragma("unroll") for (int i = 0; i < 32; ++i) scr[(2 * i + (lane >> 5)) * 33 + (lane & 31)] = w[i]; \
        LDS_WAIT(); asm volatile("" ::: "memory"); \
        _Pragma("unroll") for (int j = 0; j < 4; ++j) { const int n = (lane >> 3) + 8 * j; const LAS float* sp = scr + (8 * (lane & 7)) * 33 + n; \
            v2u o; o.x = pk4_fp8(sp[0 * 33] * W8S, sp[1 * 33] * W8S, sp[2 * 33] * W8S, sp[3 * 33] * W8S); o.y = pk4_fp8(sp[4 * 33] * W8S, sp[5 * 33] * W8S, sp[6 * 33] * W8S, sp[7 * 33] * W8S); \
            *(GAS v2u*)(d_ + (size_t)n * 1024 + 8 * (lane & 7)) = o; } \
        LDS_WAIT(); asm volatile("" ::: "memory"); } while (0)
__device__ __forceinline__ void moe_dn_filler(Frame& F, const Args& a, const int ph, const bool before) {
    const int G = F.G, c = (int)blockIdx.x, g = (c >> 3) % 5, lane = F.lane;
    LAS float* scr = (LAS float*)(F.lds + F.wave * 16384);
    const int base = ph * 32 * G + c * NWAVES + F.wave, st = NWAVES * G;
    int k = before ? 0 : g, k1 = before ? g : 4;
    while (k1 > k && base + (k1 - 1) * st >= CV_DN) --k1;
    if (k >= k1) return;
    float wa[32], wb[32];
    CV_LOAD(wa, base + k * st);
    for (;;) {
        const bool hb = k + 1 < k1;
        if (hb) CV_LOAD(wb, base + (k + 1) * st);
        CV_FINISH(wa, base + k * st);
        if (!hb) break;
        const bool ha = k + 2 < k1;
        if (ha) CV_LOAD(wa, base + (k + 2) * st);
        CV_FINISH(wb, base + (k + 1) * st);
        if (!ha) break;
        k += 2;
    }
}
#undef CV_LOAD
#undef CV_FINISH
__device__ __forceinline__ void moe_weights_to_fp8(Frame& F, const Args& a) {
    LAS float* scr = (LAS float*)(F.lds + F.wave * 16384);
    const int gw = F.vcu * NWAVES + F.wave, NGW = F.G * NWAVES, early = dn_early(F.G);
    const float* w_gu = a.in[10]; unsigned char* WGU = F.ws + WS_WGU;
    constexpr int I_GU1 = 16 * 64;
    for (int it = gw; it < CV_GU + CV_DN - early; it += NGW) {
        if (it < CV_GU) { const int e = it / I_GU1, q = it % I_GU1, kb = q / 64, nb = q % 64, n0 = 32 * nb;
            const int dst = (n0 < 1024) ? (256 * (n0 >> 7) + (n0 & 127)) : (256 * ((n0 - 1024) >> 7) + 128 + ((n0 - 1024) & 127));
            p0_transpose_item_fp8(w_gu + (size_t)e * 1024 * 2048, D, 2048, WGU + (size_t)e * 2048 * 1024, kb, nb, dst, scr, F.lane); continue; }
        moe_dn_item_fp8(F, a, it - CV_GU + early, scr);
    }
}
__device__ __forceinline__ int moe_pos(const int G) { const int c = (int)blockIdx.x, k = c >> 3; return (G % 16 == 0) ? (k & 1) * (G / 2) + (k >> 1) * 8 + (c & 7) : c; }
__device__ __forceinline__ void moe_stagger(Frame& F) {
    const int T = ((const LAS int*)(F.lds + CNT_OFF))[33], G = F.G, rem = T % G, i = moe_pos(G) - rem;
    if (rem == 0 || i < 0) return;
    const int slack = G - rem, h = (G / 2 < slack) ? G / 2 : slack;
    if (((i + 1) * h) / slack != (i * h) / slack) { __builtin_amdgcn_s_sleep(127); __builtin_amdgcn_s_sleep(127); __builtin_amdgcn_s_sleep(74); }
}
__device__ __forceinline__ void router_phase(Frame& F, const Args& a) {
    LAS int* lcnt = (LAS int*)F.lds;
    LAS int* lbase = lcnt + 32;
    LAS float* lg = (LAS float*)(F.lds + 1024) + F.wave * (16 * 33 + 16);
    const bf16* H = (const bf16*)(F.ws + WS_HB); const float* nf = a.in[7]; const float* rb = a.in[9];
    const bf16* WR = (const bf16*)(F.ws + WS_WR); unsigned char* XQ = F.ws + WS_XN;
    int* TOK = (int*)(F.ws + WS_TOK); int* SLOT = (int*)(F.ws + WS_SLOT); float* GATE = (float*)(F.ws + WS_GATE); float* RS = (float*)(F.ws + WS_RS);
    const int lane = F.lane, r16 = lane & 15, g = lane >> 4;
    LAS unsigned char* wl = F.lds + 18432;
    for (int c = F.tid; c < 64 * 128; c += NWAVES * 64) { const int row = c >> 7, ch = c & 127; *(LAS v4u*)(wl + row * 2064 + ch * 16) = *(const v4u*)(WR + (size_t)row * 1024 + ch * 8); }
    const LAS unsigned char* wlane = wl + r16 * 2064 + g * 16;
    for (int tb = blockIdx.x; tb < M / 128; tb += F.G) {
        if (F.tid < 32) lcnt[F.tid] = 0;
        __syncthreads();
        const int t0 = tb * 128 + F.wave * 16;
        const bf16* hp = H + (size_t)(t0 + r16) * D + 8 * g;
        unsigned char* xo = XQ + (size_t)(t0 + r16) * D + 8 * g;
        f32x4 acc0 = {0.f, 0.f, 0.f, 0.f}, acc1 = {0.f, 0.f, 0.f, 0.f}; float ssq = 0.f;
#pragma unroll 4
        for (int s2 = 0; s2 < 32; s2 += 2) { v2u q8[2];
#pragma unroll
          for (int hh = 0; hh < 2; ++hh) { const int s = s2 + hh;
            const v4u xw = __builtin_nontemporal_load((const v4u*)(hp + 32 * s));
            const f32x4 x0 = {bflo(xw.x), bfhi(xw.x), bflo(xw.y), bfhi(xw.y)}, x1 = {bflo(xw.z), bfhi(xw.z), bflo(xw.w), bfhi(xw.w)};
            const f32x4 w0 = *(const f32x4*)(nf + 32 * s + 8 * g), w1 = *(const f32x4*)(nf + 32 * s + 8 * g + 4);
            ssq += (x0.x * x0.x + x0.y * x0.y) + (x0.z * x0.z + x0.w * x0.w) + (x1.x * x1.x + x1.y * x1.y) + (x1.z * x1.z + x1.w * x1.w);
            const f32x4 v0 = x0 * w0, v1 = x1 * w1;
            v4u ah, al;
            ah.x = pg8::cvt_pk_bf16(v0[0], v0[1]); ah.y = pg8::cvt_pk_bf16(v0[2], v0[3]); ah.z = pg8::cvt_pk_bf16(v1[0], v1[1]); ah.w = pg8::cvt_pk_bf16(v1[2], v1[3]);
            al.x = pg8::cvt_pk_bf16(v0[0] - bflo(ah.x), v0[1] - bfhi(ah.x)); al.y = pg8::cvt_pk_bf16(v0[2] - bflo(ah.y), v0[3] - bfhi(ah.y));
            al.z = pg8::cvt_pk_bf16(v1[0] - bflo(ah.z), v1[1] - bfhi(ah.z)); al.w = pg8::cvt_pk_bf16(v1[2] - bflo(ah.w), v1[3] - bfhi(ah.w));
            q8[hh] = (v2u){pk4_fp8(v0[0] * X8S, v0[1] * X8S, v0[2] * X8S, v0[3] * X8S), pk4_fp8(v1[0] * X8S, v1[1] * X8S, v1[2] * X8S, v1[3] * X8S)};
            const bf16x8 fah = __builtin_bit_cast(bf16x8, ah), fal = __builtin_bit_cast(bf16x8, al);
            const bf16x8 bh0 = *(const LAS bf16x8*)(wlane + 64 * s), bh1 = *(const LAS bf16x8*)(wlane + 16 * 2064 + 64 * s);
            const bf16x8 bl0 = *(const LAS bf16x8*)(wlane + 32 * 2064 + 64 * s), bl1 = *(const LAS bf16x8*)(wlane + 48 * 2064 + 64 * s);
            acc0 = __builtin_amdgcn_mfma_f32_16x16x32_bf16(fah, bh0, acc0, 0, 0, 0); acc0 = __builtin_amdgcn_mfma_f32_16x16x32_bf16(fal, bh0, acc0, 0, 0, 0); acc0 = __builtin_amdgcn_mfma_f32_16x16x32_bf16(fah, bl0, acc0, 0, 0, 0);
            acc1 = __builtin_amdgcn_mfma_f32_16x16x32_bf16(fah, bh1, acc1, 0, 0, 0); acc1 = __builtin_amdgcn_mfma_f32_16x16x32_bf16(fal, bh1, acc1, 0, 0, 0); acc1 = __builtin_amdgcn_mfma_f32_16x16x32_bf16(fah, bl1, acc1, 0, 0, 0);
                  }
          *(pg8::u32x4*)(xo + 32 * (s2 + (g & 1)) + 8 * (g & 2) - 8 * g) = pg8::widen16(q8[0], q8[1]);
        }
        ssq += __shfl_xor(ssq, 16); ssq += __shfl_xor(ssq, 32);
        const float rstd = 1.0f / sqrtf(ssq * (1.f / D) + RMS_EPS);
#pragma unroll
        for (int j = 0; j < 4; ++j) { lg[(4 * g + j) * 33 + r16] = acc0[j]; lg[(4 * g + j) * 33 + 16 + r16] = acc1[j]; }
        if (lane < 16) lg[16 * 33 + lane] = rstd;
        LDS_WAIT(); asm volatile("" ::: "memory");
        int se[4] = {0, 0, 0, 0}, sp[4] = {0, 0, 0, 0}; float sg[4] = {0.f, 0.f, 0.f, 0.f}; float myr = 0.f;
        if (lane < 16) {
            myr = lg[16 * 33 + lane];
            float lv[32];
#pragma unroll
            for (int e = 0; e < 32; ++e) lv[e] = lg[lane * 33 + e] * myr + rb[e];
            unsigned used = 0u; float sv[4];
#pragma unroll
            for (int k = 0; k < 4; ++k) { float bv = -3.0e38f; int bi = 0;
#pragma unroll
                for (int e = 0; e < 32; ++e) { const bool ok = !((used >> e) & 1u) && lv[e] > bv; bv = ok ? lv[e] : bv; bi = ok ? e : bi; }
                used |= 1u << bi; se[k] = bi; sv[k] = bv; }
            const float e1 = __expf(sv[1] - sv[0]), e2 = __expf(sv[2] - sv[0]), e3 = __expf(sv[3] - sv[0]); const float inv = 1.0f / (1.0f + e1 + e2 + e3);
            sg[0] = inv; sg[1] = e1 * inv; sg[2] = e2 * inv; sg[3] = e3 * inv;
#pragma unroll
            for (int k = 0; k < 4; ++k) sp[k] = __hip_atomic_fetch_add(lcnt + se[k], 1, __ATOMIC_RELAXED, __HIP_MEMORY_SCOPE_WORKGROUP);
        }
        __syncthreads();
        if (F.tid < 32) lbase[F.tid] = (int)__hip_atomic_fetch_add((unsigned*)(F.ctl + CW_CNT + 64 * F.tid), (unsigned)lcnt[F.tid], RLX_AGENT);
        __syncthreads();
        if (lane < 16) { const int t = t0 + lane;
#pragma unroll
            for (int k = 0; k < 4; ++k) { const size_t p = (size_t)se[k] * ECAP + lbase[se[k]] + sp[k]; TOK[p] = t; GATE[p] = sg[k]; RS[p] = myr; SLOT[t * 4 + k] = (se[k] << 16) | (lbase[se[k]] + sp[k]); } }
        __syncthreads();
    }
}

__device__ __forceinline__ int moe_build_table(Frame& F, int nN, bool want_rows) {
    LAS int* tab = (LAS int*)(F.lds + TAB_OFF); LAS int* cl = (LAS int*)(F.lds + CNT_OFF); LAS int* rowsl = (LAS int*)(F.lds + ROWS_OFF);
    if (F.tid < 32) cl[F.tid] = (int)__hip_atomic_load((unsigned*)(F.ctl + CW_CNT + 64 * F.tid), RLX_AGENT);
    __syncthreads();
    int T = 0;
    for (int e = 0; e < NE; ++e) T += ((cl[e] + 255) >> 8) * nN;
    if (F.tid == 0) cl[33] = T;
    const int G = F.G, c = moe_pos(G);
    int n = (T > c) ? (T - c + G - 1) / G : 0; if (n > MAXU) n = MAXU;
    if (F.tid < n) {
        const int L = F.tid * G + c;
        int wgid = L; { const int q = T / 8, r = T % 8, xcd = wgid % 8, off = wgid / 8; wgid = (xcd < r ? xcd * (q + 1) : r * (q + 1) + (xcd - r) * q) + off; }
        int e = 0, pre = 0, rowblk = 0;
        for (; e < NE; ++e) { const int nM = (cl[e] + 255) >> 8, U = nM * nN; if (wgid < pre + U) break; pre += U; rowblk += nM; }
        if (e >= NE) e = NE - 1;
        const int nM = (cl[e] + 255) >> 8, w = wgid - pre, nig = 8 * nN, gid = w / nig, fm = gid * 8, gsz = (nM - fm) < 8 ? (nM - fm) : 8;
        const int pm = fm + ((w % nig) % gsz), pn = (w % nig) / gsz; int nv = cl[e] - pm * 256; nv = nv > 256 ? 256 : nv;
        tab[F.tid * 8 + 0] = e; tab[F.tid * 8 + 1] = pm; tab[F.tid * 8 + 2] = pn; tab[F.tid * 8 + 3] = nv; tab[F.tid * 8 + 4] = rowblk * 256;
    }
    __syncthreads();
    if (want_rows) { const int* TOK = (const int*)(F.ws + WS_TOK);
        int rv[MAXU / 2];
#pragma unroll
        for (int q = 0; q < MAXU / 2; ++q) { const int idx = F.tid + q * (NWAVES * 64), j = idx >> 8, r = idx & 255; rv[q] = 0;
            if (idx < n * 256) { const int e = tab[j * 8], pm = tab[j * 8 + 1], nv = tab[j * 8 + 3]; rv[q] = TOK[(size_t)e * ECAP + pm * 256 + (r < nv ? r : 0)]; } }
#pragma unroll
        for (int q = 0; q < MAXU / 2; ++q) { const int idx = F.tid + q * (NWAVES * 64); if (idx < n * 256) rowsl[idx] = rv[q]; }
        __syncthreads(); }
    return n;
}

__device__ __forceinline__ void final_phase(Frame& F, const Args& a) {
    const int lane_ = (int)__builtin_amdgcn_mbcnt_hi(~0u, __builtin_amdgcn_mbcnt_lo(~0u, 0u));
    float* OUT = a.out; const bf16* H = (const bf16*)(F.ws + WS_HB); const unsigned char* OB = F.ws + WS_OBUF; const float* fw = a.in[14]; const int* POS = (const int*)(F.ws + WS_SLOT);
    const int gw = F.vcu * NWAVES + F.wave, NGW = F.G * NWAVES;
    LAS int* rbase = (LAS int*)(F.lds + CNT_OFF);
    if (F.tid == 0) { int acc = 0; for (int e = 0; e < NE; ++e) { rbase[e] = acc; acc += (((int)__hip_atomic_load((unsigned*)(F.ctl + CW_CNT + 64 * e), RLX_AGENT) + 255) >> 8) * 256; } }
    __syncthreads();
    f32x4 wv[4];
#pragma unroll
    for (int j = 0; j < 4; ++j) wv[j] = *((const f32x4*)fw + lane_ + 64 * j);
    for (int m = gw; m < M; m += NGW) {
        GAS f32x4* hr = (GAS f32x4*)(OUT + (size_t)m * D) + lane_;
        const GAS v2u* hbr = (const GAS v2u*)(H + (size_t)m * D) + lane_;
        f32x4 v[4]; float s = 0.f;
#pragma unroll
        for (int j = 0; j < 4; ++j) { const v2u hw = __builtin_nontemporal_load(hbr + 64 * j); v[j] = (f32x4){bflo(hw.x), bfhi(hw.x), bflo(hw.y), bfhi(hw.y)}; }
        const v4i_t ps = *(const v4i_t*)(POS + (size_t)m * 4);
        int orow[4];
#pragma unroll
        for (int k = 0; k < 4; ++k) orow[k] = rbase[ps[k] >> 16] + (ps[k] & 0xffff);
        f32x4 y[4];
#pragma unroll
        for (int j = 0; j < 4; ++j) y[j] = (f32x4){0.f, 0.f, 0.f, 0.f};
#pragma unroll
        for (int k = 0; k < 4; ++k) { const GAS unsigned* op = (const GAS unsigned*)(OB + (size_t)orow[k] * D) + lane_;
#pragma unroll
            for (int j = 0; j < 4; ++j) { const int w = (int)__builtin_nontemporal_load(op + 64 * j);
                const f32x2 lo = __builtin_amdgcn_cvt_pk_f32_fp8(w, false), hi = __builtin_amdgcn_cvt_pk_f32_fp8(w, true);
                y[j].x += lo.x; y[j].y += lo.y; y[j].z += hi.x; y[j].w += hi.y; } }
#pragma unroll
        for (int j = 0; j < 4; ++j) v[j] += y[j] * (1.0f / O8S);
#pragma unroll
        for (int j = 0; j < 4; ++j) s += (v[j].x * v[j].x + v[j].y * v[j].y) + (v[j].z * v[j].z + v[j].w * v[j].w);
        const float rstd = 1.0f / sqrtf(wave_sum(s) * (1.f / D) + RMS_EPS);
#pragma unroll
        for (int j = 0; j < 4; ++j) hr[64 * j] = v[j] * rstd * wv[j];
    }
}

__global__ void __launch_bounds__(NWAVES * 64, 2) fwd_kernel(Args args) {
    extern __shared__ __attribute__((aligned(16))) unsigned char lds[];
    Frame F;
    F.lds = (LAS unsigned char*)lds;
    F.MISC = (volatile LAS unsigned*)(F.lds + MISC_OFF);
    F.tid = threadIdx.x; F.lane = F.tid & 63; F.wave = __builtin_amdgcn_readfirstlane(F.tid >> 6);
    F.G = gridDim.x; { const int bx = blockIdx.x; F.vcu = (F.G % 8 == 0) ? (bx % 8) * (F.G / 8) + bx / 8 : bx; }
    F.ws = args.ws; F.ctl = (gu32*)(args.ws + WS_CTL);
    if (F.tid < 32) F.MISC[F.tid] = 0u;
    __syncthreads();
    XcdBarrier bar = xcd_barrier_post((unsigned*)(F.ctl + CW_BAR), F.MISC + 8);
    const int lo = args.ph_lo, hi = args.ph_hi;
#define IN(k) (lo <= (k) && (k) < hi)
#define BOTH(k) (IN(k) && IN((k) + 1))
#define GRID_BAR() xcd_barrier(bar)

#ifndef DUP_PHASE
#define DUP_PHASE (-1)
#endif
#define PHASE_BEGIN(k) if (IN(k)) { for (int rep_ = 0; rep_ < ((DUP_PHASE == (k)) ? 2 : 1); ++rep_) { if (rep_) GRID_BAR();
#define PHASE_END(k) } if (BOTH(k)) GRID_BAR(); }
    PHASE_BEGIN(0) p0_prologue(F, args); PHASE_END(0)
    PHASE_BEGIN(1)
        pg8::DenseOrder S; S.init(F.ws + WS_XN, F.ws + WS_WIN, M, NPROJ, D, F.G, (int)blockIdx.x);
        pg8::EpiInProj E{(bf16*)(F.ws + WS_PROJ), (const float*)(F.ws + WS_LB)};
        moe_dn_filler(F, args, 0, true); __syncthreads();
        pg8::gemm_phase<pg8::EpiInProj, pg8::DenseOrder, false, true>(F.lds, D, S, E);
        moe_dn_filler(F, args, 0, false);
    PHASE_END(1)
    PHASE_BEGIN(2) hgrn_units2<0>(F, args, (int)blockIdx.x, F.G); attn_mfma(F, args, F.vcu, F.G); PHASE_END(2)
    PHASE_BEGIN(3) hgrn_scan(F); PHASE_END(3)
    PHASE_BEGIN(4) hgrn_units2<1>(F, args, (int)blockIdx.x, F.G); PHASE_END(4)
    PHASE_BEGIN(5)
        pg8::DenseOrder S; S.init(F.ws + WS_MIX, F.ws + WS_WOUT, M, D, D, F.G, (int)blockIdx.x);
        pg8::EpiOutProj E{args.in[0], (bf16*)(F.ws + WS_HB)};
        moe_dn_filler(F, args, 1, true); __syncthreads();
        pg8::gemm_phase<pg8::EpiOutProj, pg8::DenseOrder, false, true>(F.lds, D, S, E);
        moe_dn_filler(F, args, 1, false);
    PHASE_END(5)
    PHASE_BEGIN(6) moe_weights_to_fp8(F, args); __syncthreads(); router_phase(F, args); PHASE_END(6)
    PHASE_BEGIN(7)
        const int n = moe_build_table(F, 8, true);
        pg8::MoeOrder S{(const LAS int*)(F.lds + TAB_OFF), (const LAS int*)(F.lds + ROWS_OFF), n, (const char*)(F.ws + WS_XN), (const char*)(F.ws + WS_WGU), (size_t)2048 * 1024, D / 2, true};
        pg8::EpiSwiglu E{F.ws + WS_ACT, args.in[11], (const float*)(F.ws + WS_RS)};
        moe_stagger(F);
        pg8::gemm_phase<pg8::EpiSwiglu, pg8::MoeOrder, true, true, true>(F.lds, D / 2, S, E, F.lds + CB_OFF);
    PHASE_END(7)
    PHASE_BEGIN(8)
        const int n = moe_build_table(F, 4, false);
        pg8::MoeOrder S{(const LAS int*)(F.lds + TAB_OFF), (const LAS int*)(F.lds + ROWS_OFF), n, (const char*)(F.ws + WS_ACT), (const char*)(F.ws + WS_WDN), (size_t)1024 * 1024, D / 2, false};
        pg8::EpiDown E{F.ws + WS_OBUF, args.in[13], (const float*)(F.ws + WS_GATE)};
        moe_stagger(F);
        pg8::gemm_phase<pg8::EpiDown, pg8::MoeOrder, false, true, true>(F.lds, D / 2, S, E, F.lds + CB_OFF);
    PHASE_END(8)
    PHASE_BEGIN(9) final_phase(F, args); PHASE_END(9)
#undef IN
#undef BOTH
#undef GRID_BAR
}


#ifndef MK_N_LAUNCHES
#define MK_N_LAUNCHES 1
#endif
static void fill_buckets(Args& a) {
    const int dil[3] = {1, 4, 16};
    for (int p = 0; p < 3; ++p) for (int j = 0; j < 136; ++j) {
        int bkt = 0;
        if (j <= 128) { const int n = j * dil[p];
            if (n < 16) bkt = n;
            else { int large = 16 + (int)(std::log((double)n / 16.0) / std::log(2048.0 / 16.0) * 16.0); bkt = large < 31 ? large : 31; } }
        a.bkt[p][j] = (unsigned char)bkt; }
}
extern "C" void kernel_launch(void* const* d_in, const int* in_sizes, int n_in, void* d_out, int out_size, void* d_ws, size_t ws_size, hipStream_t stream) {
    static int grid = 0;
    if (grid == 0) {
        if (n_in != 15 || in_sizes[0] != M * D || out_size != M * D || ws_size < WS_END) { fprintf(stderr, "kernel_launch: unexpected shapes / workspace (n_in %d, ws %zu < %zu); nothing launched\n", n_in, ws_size, (size_t)WS_END); grid = -1; return; }
        int dev = 0, cus = 0;
        if (hipGetDevice(&dev) != hipSuccess || hipDeviceGetAttribute(&cus, hipDeviceAttributeMultiprocessorCount, dev) != hipSuccess) { grid = -1; return; }
        if (hipFuncSetAttribute((const void*)fwd_kernel, hipFuncAttributeMaxDynamicSharedMemorySize, LDS_BYTES) != hipSuccess) { fprintf(stderr, "kernel_launch: hipFuncSetAttribute failed\n"); grid = -1; return; }
        int per_cu = 0;
        if (hipOccupancyMaxActiveBlocksPerMultiprocessor(&per_cu, (const void*)fwd_kernel, NWAVES * 64, LDS_BYTES) != hipSuccess || per_cu < 1) fprintf(stderr, "kernel_launch: occupancy query says %d\n", per_cu);
        (void)hipGetLastError();
        grid = cus;
    }
    if (grid < 0) return;
    if (hipMemsetAsync((char*)d_ws + WS_CTL, 0, CTL_ZERO_BYTES, stream) != hipSuccess) return;
    Args a{};
    for (int i = 0; i < 15; ++i) a.in[i] = (const float*)d_in[i];
    a.out = (float*)d_out; a.ws = (unsigned char*)d_ws;
    fill_buckets(a);
    constexpr int NPH = 10;
#if MK_N_LAUNCHES == 1
    a.ph_lo = 0; a.ph_hi = NPH;
    hipLaunchKernelGGL(fwd_kernel, dim3(grid), dim3(NWAVES * 64), LDS_BYTES, stream, a);
#else
    for (int p = 0; p < NPH; ++p) { a.ph_lo = p; a.ph_hi = p + 1; hipLaunchKernelGGL(fwd_kernel, dim3(grid), dim3(NWAVES * 64), LDS_BYTES, stream, a); }
#endif
}
```

```cpp
#include <hip/hip_runtime.h>
#include <cstdio>
#include <cstdint>
#include <cmath>

#define GAS __attribute__((address_space(1)))
#define LAS __attribute__((address_space(3)))
typedef unsigned short bf16;
typedef unsigned v4u __attribute__((ext_vector_type(4)));
typedef unsigned v2u __attribute__((ext_vector_type(2)));
typedef float f32x4 __attribute__((ext_vector_type(4)));
typedef float f32x2 __attribute__((ext_vector_type(2)));
typedef short bf16x8 __attribute__((ext_vector_type(8)));
typedef GAS unsigned gu32;
#define RLX_AGENT __ATOMIC_RELAXED, __HIP_MEMORY_SCOPE_AGENT
#define LDS_WAIT() asm volatile("s_waitcnt lgkmcnt(0)" ::: "memory")
#define VM_WAIT() asm volatile("s_waitcnt vmcnt(0)" ::: "memory")

constexpr int D = 1024, BATCH = 8, SEQ = 4096, M = BATCH * SEQ;
constexpr int AH = 8, HD = 64;
constexpr int HH = 4, HK = 128;
constexpr int NPROJ = 3584;
constexpr int NE = 32, TOPK = 4;
constexpr int ECAP = 32768;
constexpr float RMS_EPS = 1e-5f;
constexpr float LOG2E = 1.4426950408889634f, LN2 = 0.6931471805599453f;
constexpr float QSCALE = 0.125f * LOG2E;

constexpr size_t MiB = 1u << 20;
constexpr size_t WS_CTL = 0, CTL_ZERO_BYTES = 48 * 1024;
constexpr size_t WS_LB = 1 * MiB;
constexpr size_t WS_WR = 1 * MiB + 65536;
constexpr size_t WS_WIN = 2 * MiB;
constexpr size_t WS_WOUT = 9 * MiB;
constexpr size_t WS_TOK = 11 * MiB, WS_SLOT = 15 * MiB, WS_GATE = 19 * MiB, WS_RS = 23 * MiB;
constexpr size_t WS_LSE = 27 * MiB;
constexpr size_t WS_WDN = 32 * MiB;
constexpr size_t WS_WGU = 96 * MiB;
constexpr size_t WS_XN = 224 * MiB;
constexpr size_t WS_MIX = 288 * MiB;
constexpr size_t WS_HB = 160 * MiB;
constexpr size_t WS_OBUF = 488 * MiB;
constexpr size_t WS_PROJ = 352 * MiB;
constexpr size_t WS_ATTP = 576 * MiB;
constexpr size_t WS_ACT = 352 * MiB;
constexpr size_t WS_HO = 672 * MiB;
constexpr size_t WS_END = 736 * MiB;
constexpr size_t PROJ_STRIDE = (size_t)M * 512;
constexpr int CW_TMO = 0, CW_CODE = 1, CW_BAR = 4096, CW_CNT = 8192;
static_assert((CW_BAR + 3456) <= CW_CNT && (size_t)(CW_CNT + 64 * 32) * 4 <= CTL_ZERO_BYTES, "control words inside the per-call memset");

constexpr int RING_BYTES = 131072;
constexpr int ROWS_OFF = RING_BYTES;
constexpr int MAXU = 20;
constexpr int TAB_OFF = ROWS_OFF + MAXU * 1024;
constexpr int CNT_OFF = TAB_OFF + MAXU * 32;
constexpr int MISC_OFF = CNT_OFF + 256;
constexpr int CB_OFF = MISC_OFF + 128;
constexpr int LDS_BYTES = 159744;
static_assert(CB_OFF % 16 == 0 && CB_OFF + 4096 <= LDS_BYTES, "LDS map");
constexpr int NWAVES = 8;

__device__ __forceinline__ unsigned f2bf(float f) { unsigned u = __builtin_bit_cast(unsigned, f); return (u + 0x7fffu + ((u >> 16) & 1u)) >> 16; }
__device__ __forceinline__ unsigned pk2(float lo, float hi) { unsigned r; asm volatile("v_cvt_pk_bf16_f32 %0, %1, %2" : "=v"(r) : "v"(lo), "v"(hi)); return r; }
__device__ __forceinline__ float bf2f(unsigned b) { return __builtin_bit_cast(float, b << 16); }
__device__ __forceinline__ float bflo(unsigned w) { return __builtin_bit_cast(float, w << 16); }
__device__ __forceinline__ float bfhi(unsigned w) { return __builtin_bit_cast(float, w & 0xffff0000u); }
typedef int v8i_t __attribute__((ext_vector_type(8)));
typedef int v4i_t __attribute__((ext_vector_type(4)));
constexpr float X8S = 16.0f, W8S = 256.0f, A8S = 8.0f, O8S = 32.0f;
__device__ __forceinline__ float clamp448(float x) { return __builtin_amdgcn_fmed3f(x, -448.0f, 448.0f); }
__device__ __forceinline__ unsigned pk4_fp8(float a, float b, float c, float d) { int w = 0; w = __builtin_amdgcn_cvt_pk_fp8_f32(clamp448(a), clamp448(b), w, false); w = __builtin_amdgcn_cvt_pk_fp8_f32(clamp448(c), clamp448(d), w, true); return (unsigned)w; }
__device__ __forceinline__ float fexp2(float x) { return __builtin_amdgcn_exp2f(x); }
__device__ __forceinline__ float frcp(float x) { return __builtin_amdgcn_rcpf(x); }
__device__ __forceinline__ float sigmoidf_(float x) { return frcp(1.0f + fexp2(-x * LOG2E)); }
__device__ __forceinline__ float siluf_(float x) { return x * sigmoidf_(x); }

namespace pg8 {
typedef unsigned u32x4 __attribute__((ext_vector_type(4)));
constexpr int BM = 256, BK = 64, HALF = 128, HTB = HALF * BK * 2, STAGE_BYTES = 8 * HTB, NXCD = 8, WGM = 8;
__host__ __device__ __forceinline__ int lds_byte(int r, int c) { const int st = (r >> 4) * 2 + (c >> 5), rr = r & 15, cc = c & 31, ob = rr * 64 + cc * 2; return st * 1024 + (ob ^ (((ob >> 9) & 1) << 5)); }
__host__ __device__ __forceinline__ void stage_rc(int b, int& R, int& C) { const int st = b / 1024, sb = b % 1024, swz = sb ^ (((sb >> 9) & 1) << 5); R = (st >> 1) * 16 + swz / 64; C = (st & 1) * 32 + (swz % 64) / 2; }
__host__ __device__ __forceinline__ int perm32(int rho) { const int n = rho >> 4, i = rho & 15; return 8 * (i >> 2) + 4 * n + (i & 3); }

struct Unit { const char* A; const char* B; const LAS int* rows; int pm, pn, e, nvalid, rowbase; };
__device__ __forceinline__ unsigned cvt_pk_bf16(float lo, float hi) { unsigned r; asm volatile("v_cvt_pk_bf16_f32 %0, %1, %2" : "=v"(r) : "v"(lo), "v"(hi)); return r; }

struct DenseOrder {
    const char* A; const char* B; int K, nM, nN, nwg, G, c;
    __device__ __forceinline__ void init(const void* A_, const void* B_, int M_, int N_, int K_, int G_, int c_) { A = (const char*)A_; B = (const char*)B_; K = K_; nM = M_ / BM; nN = N_ / BM; nwg = nM * nN; G = G_; c = c_; }
    __device__ __forceinline__ bool next(int i, Unit& u) const {
        const long L = (long)i * G + c; if (L >= nwg) return false;
        int wgid = (int)L; { const int q = nwg / NXCD, r = nwg % NXCD, xcd = wgid % NXCD, off = wgid / NXCD; wgid = (xcd < r ? xcd * (q + 1) : r * (q + 1) + (xcd - r) * q) + off; }
        const int nig = WGM * nN, gid = wgid / nig, fm = gid * WGM, gsz = (nM - fm) < WGM ? (nM - fm) : WGM;
        u.pm = fm + ((wgid % nig) % gsz); u.pn = (wgid % nig) / gsz; u.e = 0; u.nvalid = 256; u.rowbase = 0; u.rows = nullptr;
        u.A = A + (size_t)u.pm * ((size_t)BM * K * 2); u.B = B + (size_t)u.pn * ((size_t)BM * K * 2); return true;
    }
};
struct MoeOrder {
    const LAS int* tab; const LAS int* rows; int n; const char* A; const char* B; size_t bstride; int K; bool gather;
    __device__ __forceinline__ bool next(int i, Unit& u) const {
        if (i >= n) return false;
        const LAS int* t = tab + i * 8;
        u.e = __builtin_amdgcn_readfirstlane(t[0]); u.pm = __builtin_amdgcn_readfirstlane(t[1]); u.pn = __builtin_amdgcn_readfirstlane(t[2]);
        u.nvalid = __builtin_amdgcn_readfirstlane(t[3]); u.rowbase = __builtin_amdgcn_readfirstlane(t[4]);
        u.B = B + (size_t)u.e * bstride + (size_t)u.pn * ((size_t)BM * K * 2);
        if (gather) { u.A = A; u.rows = rows + i * 256; }
        else { u.A = A + (size_t)(u.rowbase + u.pm * 256) * ((size_t)K * 2); u.rows = nullptr; }
        return true;
    }
};

template <class Epi, class Sched, bool GATHER, bool ALIGN_EPI, bool FP8 = false>
__device__ __forceinline__ void gemm_phase(LAS unsigned char* lds, const int K, const Sched& S, const Epi& E, LAS unsigned char* cbuf = nullptr) {
    const int tid = threadIdx.x, wid = __builtin_amdgcn_readfirstlane(tid >> 6), lane = tid & 63, wr = wid >> 2, wc = wid & 3, fr = lane & 15, fq = lane >> 4;
    const int nt = K / BK;
    unsigned voffA[2], voffB[2], cA2[2]; int rA[2];
#pragma unroll
    for (int i = 0; i < 2; ++i) { int R, C; stage_rc(tid * 16 + i * 8192, R, C); const int Rb = Epi::PERM ? ((R & ~31) + perm32(R & 31)) : R;
        voffA[i] = (unsigned)(R * K + C) * 2u; voffB[i] = (unsigned)(Rb * K + C) * 2u; rA[i] = R; cA2[i] = (unsigned)C * 2u; }
    const size_t kstep = (size_t)(BK * 2);
    const size_t hstep = (size_t)HALF * K * 2;
    const unsigned ldsw = (unsigned)wid * 1024u;
    const int aoff = lds_byte(wr * 64 + fr, fq * 8), boff = lds_byte(wc * 32 + fr, fq * 8);
#define PG8_SA(b, h) (((b) * 2 + (h)) * HTB)
#define PG8_SB(b, h) ((4 + (b) * 2 + (h)) * HTB)
#define PG8_STAGE(bufoff, gbase, voff) do { _Pragma("unroll") for (int _i = 0; _i < 2; ++_i) \
        __builtin_amdgcn_global_load_lds((const unsigned*)((const char*)(gbase) + (voff)[_i]), (LAS unsigned*)(lds + (bufoff) + ldsw + _i * 8192), 16, 0, 0); } while (0)
#define PG8_STAGE_A(b, h, aptr, G) do { if constexpr (GATHER) { PG8_STAGE(PG8_SA(b, h), aptr, G[h]); } else { PG8_STAGE(PG8_SA(b, h), (aptr) + (h) * hstep, voffA); } } while (0)
#define PG8_LD8(addr) __builtin_shufflevector(*(const LAS v4i_t*)(addr), *(const LAS v4i_t*)((addr) + 1024), 0, 1, 2, 3, 4, 5, 6, 7)
#define PG8_LDA(dst, b, h) do { if constexpr (FP8) { _Pragma("unroll") for (int m = 0; m < 4; ++m) dst##8[m] = PG8_LD8(lds + PG8_SA(b, h) + aoff + m * 2048); } \
        else { _Pragma("unroll") for (int m = 0; m < 4; ++m) _Pragma("unroll") for (int k = 0; k < 2; ++k) dst[m][k] = *(const LAS bf16x8*)(lds + PG8_SA(b, h) + aoff + m * 2048 + k * 1024); } } while (0)
#define PG8_LDB(dst, b, h) do { if constexpr (FP8) { _Pragma("unroll") for (int n = 0; n < 2; ++n) dst##8[n] = PG8_LD8(lds + PG8_SB(b, h) + boff + n * 2048); } \
        else { _Pragma("unroll") for (int n = 0; n < 2; ++n) _Pragma("unroll") for (int k = 0; k < 2; ++k) dst[n][k] = *(const LAS bf16x8*)(lds + PG8_SB(b, h) + boff + n * 2048 + k * 1024); } } while (0)
#define PG8_MMA(ai, bj, At, Bt) do { __builtin_amdgcn_s_setprio(1); \
        if constexpr (FP8) { _Pragma("unroll") for (int m = 0; m < 4; ++m) _Pragma("unroll") for (int n = 0; n < 2; ++n) \
            asm volatile("v_mfma_f32_16x16x128_f8f6f4 %0, %1, %2, %0" : "+v"(acc[ai][bj][m][n]) : "v"(Bt##8[n]), "v"(At##8[m])); } \
        else { _Pragma("unroll") for (int k = 0; k < 2; ++k) _Pragma("unroll") for (int m = 0; m < 4; ++m) _Pragma("unroll") for (int n = 0; n < 2; ++n) \
            asm volatile("v_mfma_f32_16x16x32_bf16 %0, %1, %2, %0" : "+v"(acc[ai][bj][m][n]) : "v"(Bt[n][k]), "v"(At[m][k])); } \
        __builtin_amdgcn_s_setprio(0); } while (0)
#define PG8_MMA0(ai, bj, At, Bt) do { __builtin_amdgcn_s_setprio(1); \
        if constexpr (FP8) { _Pragma("unroll") for (int m = 0; m < 4; ++m) _Pragma("unroll") for (int n = 0; n < 2; ++n) \
            asm volatile("v_mfma_f32_16x16x128_f8f6f4 %0, %1, %2, 0" : "=v"(acc[ai][bj][m][n]) : "v"(Bt##8[n]), "v"(At##8[m])); } \
        else { _Pragma("unroll") for (int m = 0; m < 4; ++m) _Pragma("unroll") for (int n = 0; n < 2; ++n) \
            asm volatile("v_mfma_f32_16x16x32_bf16 %0, %1, %2, 0" : "=v"(acc[ai][bj][m][n]) : "v"(Bt[n][0]), "v"(At[m][0])); \
            _Pragma("unroll") for (int m = 0; m < 4; ++m) _Pragma("unroll") for (int n = 0; n < 2; ++n) \
            asm volatile("v_mfma_f32_16x16x32_bf16 %0, %1, %2, %0" : "+v"(acc[ai][bj][m][n]) : "v"(Bt[n][1]), "v"(At[m][1])); } \
        __builtin_amdgcn_s_setprio(0); } while (0)
#define PG8_WAIT_V(n) asm volatile("s_waitcnt vmcnt(" #n ")" ::: "memory")
#define PG8_WAIT_L(n) asm volatile("s_waitcnt lgkmcnt(" #n ")" ::: "memory")
#define PG8_BAR __builtin_amdgcn_s_barrier()
#define PG8_SCHED __builtin_amdgcn_sched_barrier(0)
#define PG8_GLOAD(G, u) do { _Pragma("unroll") for (int _h = 0; _h < 2; ++_h) _Pragma("unroll") for (int _i = 0; _i < 2; ++_i) { int _r = rA[_i] + HALF * _h; _r = _r < (u).nvalid ? _r : 0; \
        G[_h][_i] = (unsigned)(u).rows[_r] * (unsigned)(K * 2) + cA2[_i]; } } while (0)
#define PG8_ITER(FIRSTV) do { constexpr bool FIRST_ = (FIRSTV); \
            const bool last = (t == nt - 2); \
            const char* a1 = cA + (size_t)(t + 1) * kstep; \
            const char* a2 = last ? nA : cA + (size_t)(t + 2) * kstep; const char* b2 = last ? nB : cB + (size_t)(t + 2) * kstep; \
            const char* a3 = a2 + kstep; const char* b3 = b2 + kstep; \
            const bool relax = (t == 0) && (ui > 0); \
            PG8_LDB(B0, 0, 0); PG8_LDB(B1, 0, 1); PG8_SCHED; PG8_LDA(At, 0, 0); PG8_STAGE_A(1, 1, a1, gc); \
            if constexpr (GATHER) { if (last && has_next) { PG8_GLOAD(gc, nxt); } } \
            if (relax) { asm volatile("s_waitcnt vmcnt(%0)" :: "n"(8 + Epi::NE) : "memory"); } else { PG8_WAIT_V(8); } \
            PG8_WAIT_L(0); PG8_BAR; if constexpr (FIRST_) { PG8_MMA0(0, 0, At, B0); PG8_MMA0(0, 1, At, B1); } else { PG8_MMA(0, 0, At, B0); PG8_MMA(0, 1, At, B1); } PG8_BAR; PG8_SCHED; \
            PG8_LDA(At, 0, 1); PG8_STAGE(PG8_SB(0, 0), b2, voffB); PG8_STAGE(PG8_SB(0, 1), b2 + hstep, voffB); PG8_STAGE_A(0, 0, a2, gc); \
            if (relax) { asm volatile("s_waitcnt vmcnt(%0)" :: "n"(8 + Epi::NE) : "memory"); } else { PG8_WAIT_V(8); } \
            PG8_WAIT_L(0); PG8_BAR; if constexpr (FIRST_) { PG8_MMA0(1, 0, At, B0); PG8_MMA0(1, 1, At, B1); } else { PG8_MMA(1, 0, At, B0); PG8_MMA(1, 1, At, B1); } PG8_BAR; PG8_SCHED; \
            PG8_LDB(B0, 1, 0); PG8_LDB(B1, 1, 1); PG8_SCHED; PG8_LDA(At, 1, 0); PG8_STAGE_A(0, 1, a2, gc); \
            PG8_WAIT_V(8); PG8_WAIT_L(0); PG8_BAR; PG8_MMA(0, 0, At, B0); PG8_MMA(0, 1, At, B1); PG8_BAR; PG8_SCHED; \
            PG8_LDA(At, 1, 1); PG8_STAGE(PG8_SB(1, 0), b3, voffB); PG8_STAGE(PG8_SB(1, 1), b3 + hstep, voffB); PG8_STAGE_A(1, 0, a3, gc); \
            PG8_WAIT_V(8); PG8_WAIT_L(0); PG8_BAR; PG8_MMA(1, 0, At, B0); PG8_MMA(1, 1, At, B1); PG8_BAR; PG8_SCHED; \
        } while (0)
    Unit cur, nxt; int ui = 0;
    if (!S.next(0, cur)) return;
    f32x4 acc[2][2][4][2];
    bf16x8 At[4][2], B0[2][2], B1[2][2]; v8i_t At8[4], B08[2], B18[2];
    unsigned gc[2][2] = {{0u, 0u}, {0u, 0u}};
    if constexpr (GATHER) { PG8_GLOAD(gc, cur); }
    const char* cA = cur.A; const char* cB = cur.B;
    PG8_STAGE(PG8_SB(0, 0), cB, voffB); PG8_STAGE(PG8_SB(0, 1), cB + hstep, voffB); PG8_STAGE_A(0, 0, cA, gc); PG8_STAGE_A(0, 1, cA, gc);
    if (wr == 1) PG8_BAR;
    PG8_WAIT_V(2); PG8_BAR;
    PG8_STAGE(PG8_SB(1, 0), cB + kstep, voffB); PG8_STAGE_A(1, 0, cA + kstep, gc); PG8_STAGE(PG8_SB(1, 1), cB + hstep + kstep, voffB);
    PG8_WAIT_V(6); PG8_BAR;
    for (;;) {
        if constexpr (Epi::HAS_PF) { if (wid == 0) E.prefetch(cur, cbuf + (ui & 1) * 2048, lane); }
        const bool has_next = S.next(ui + 1, nxt);
        const char* nA = has_next ? nxt.A : cA; const char* nB = has_next ? nxt.B : cB;
        { const int t = 0; PG8_ITER(true); }
#pragma unroll 1
        for (int t = 2; t < nt; t += 2) { PG8_ITER(false); }
        if constexpr (ALIGN_EPI) { if (wr == 0) PG8_BAR; }
        { PG8_SCHED; asm volatile("s_nop 15\n\ts_nop 15" ::: "memory"); PG8_SCHED; }
        E(acc, cur, wr, wc, fr, fq, cbuf + (ui & 1) * 2048);
        if (!has_next) break;
        cur = nxt; cA = nA; cB = nB; ++ui;
        if constexpr (ALIGN_EPI) { if (wr == 1) PG8_BAR; }
    }
    PG8_WAIT_V(0);
    if constexpr (!ALIGN_EPI) { if (wr == 0) PG8_BAR; }
    PG8_BAR;
#undef PG8_SA
#undef PG8_SB
#undef PG8_STAGE
#undef PG8_STAGE_A
#undef PG8_LDA
#undef PG8_LDB
#undef PG8_MMA
#undef PG8_MMA0
#undef PG8_ITER
#undef PG8_LD8
#undef PG8_WAIT_V
#undef PG8_WAIT_L
#undef PG8_BAR
#undef PG8_SCHED
#undef PG8_GLOAD
}

struct EpiInProj {
    static constexpr bool PERM = true, HAS_PF = false; static constexpr int NE = 12;
    bf16* proj; const float* lb;
    __device__ __forceinline__ void operator()(const f32x4 (&acc)[2][2][4][2], const Unit& u, int wr, int wc, int fr, int fq, const LAS unsigned char*) const {
        const int t = u.pn >> 1;
        bf16* base = proj + (size_t)t * PROJ_STRIDE;
        const int row0 = u.pm * BM + wr * 64 + fr, col0 = (u.pn & 1) * 256 + wc * 32 + 8 * fq;
        f32x4 lbv[2][2];
#pragma unroll
        for (int bj = 0; bj < 2; ++bj)
#pragma unroll
            for (int n = 0; n < 2; ++n) lbv[bj][n] = (t == 4) ? *(const f32x4*)(lb + col0 + bj * HALF + 4 * n) : (f32x4){0.f, 0.f, 0.f, 0.f};
#pragma unroll
        for (int ai = 0; ai < 2; ++ai)
#pragma unroll
            for (int m = 0; m < 4; ++m) { bf16* rowp = base + (size_t)(row0 + ai * HALF + m * 16) * 512 + col0;
#pragma unroll
                for (int bj = 0; bj < 2; ++bj) { f32x4 v[2] = {acc[ai][bj][m][0], acc[ai][bj][m][1]};
                    if (t == 0) { v[0] = v[0] * QSCALE; v[1] = v[1] * QSCALE; }
                    else if (t == 3) {
#pragma unroll
                        for (int n = 0; n < 2; ++n)
#pragma unroll
                            for (int j = 0; j < 4; ++j) v[n][j] = siluf_(v[n][j]) * 0.08838834764831845f; }
                    else if (t == 4) {
#pragma unroll
                        for (int n = 0; n < 2; ++n)
#pragma unroll
                            for (int j = 0; j < 4; ++j) { const float l = lbv[bj][n][j]; const float f = l + (1.0f - l) * sigmoidf_(v[n][j]); v[n][j] = __builtin_amdgcn_logf(f) * LN2; } }
                    else if (t == 6) {
#pragma unroll
                        for (int n = 0; n < 2; ++n)
#pragma unroll
                            for (int j = 0; j < 4; ++j) v[n][j] = siluf_(v[n][j]); }
                    u32x4 w; w.x = cvt_pk_bf16(v[0][0], v[0][1]); w.y = cvt_pk_bf16(v[0][2], v[0][3]); w.z = cvt_pk_bf16(v[1][0], v[1][1]); w.w = cvt_pk_bf16(v[1][2], v[1][3]);
                    *(u32x4*)(rowp + bj * HALF) = w; } }
    }
};
struct EpiOutProj {
    static constexpr bool PERM = true, HAS_PF = false; static constexpr int NE = 28;
    const float* x; bf16* hb;
    __device__ __forceinline__ void operator()(const f32x4 (&acc)[2][2][4][2], const Unit& u, int wr, int wc, int fr, int fq, const LAS unsigned char*) const {
        const int row0 = u.pm * BM + wr * 64 + fr, col0 = u.pn * BM + wc * 32 + 8 * fq;
#pragma unroll
        for (int ai = 0; ai < 2; ++ai)
#pragma unroll
            for (int m = 0; m < 4; ++m) { const size_t off = (size_t)(row0 + ai * HALF + m * 16) * D + col0;
#pragma unroll
                for (int bj = 0; bj < 2; ++bj) { const size_t p = off + bj * HALF;
                    const f32x4 v0 = __builtin_nontemporal_load((const f32x4*)(x + p)) + acc[ai][bj][m][0], v1 = __builtin_nontemporal_load((const f32x4*)(x + p + 4)) + acc[ai][bj][m][1];
                    u32x4 w; w.x = cvt_pk_bf16(v0[0], v0[1]); w.y = cvt_pk_bf16(v0[2], v0[3]); w.z = cvt_pk_bf16(v1[0], v1[1]); w.w = cvt_pk_bf16(v1[2], v1[3]);
                    *(u32x4*)(hb + p) = w; } }
    }
};
__device__ __forceinline__ u32x4 widen16(v2u a, v2u b) {
    const auto r0 = __builtin_amdgcn_permlane16_swap(a.x, b.x, false, false), r1 = __builtin_amdgcn_permlane16_swap(a.y, b.y, false, false);
    return (u32x4){r0[0], r1[0], r0[1], r1[1]};
}
struct EpiSwiglu {
    static constexpr bool PERM = true, HAS_PF = true; static constexpr int NE = 4;
    unsigned char* act; const float* bgu; const float* rs;
    __device__ __forceinline__ void prefetch(const Unit& u, LAS unsigned char* cb, int lane) const {
        const float* b0 = bgu + (size_t)u.e * 2048 + u.pn * 128 + (lane < 32 ? lane * 4 : 1024 + (lane - 32) * 4);
        __builtin_amdgcn_global_load_lds((const unsigned*)b0, (LAS unsigned*)cb, 16, 0, 0);
        __builtin_amdgcn_global_load_lds((const unsigned*)(rs + (size_t)u.e * ECAP + u.pm * 256 + lane * 4), (LAS unsigned*)(cb + 1024), 16, 0, 0);
    }
    __device__ __forceinline__ void operator()(const f32x4 (&acc)[2][2][4][2], const Unit& u, int wr, int wc, int fr, int fq, const LAS unsigned char* cb) const {
        const int cl = wc * 32 + 8 * fq, odd = fq & 1, colW = u.pn * 128 + wc * 32 + 8 * (fq & 2);
        f32x4 bgv[2], buv[2];
#pragma unroll
        for (int n = 0; n < 2; ++n) { bgv[n] = *(const LAS f32x4*)(cb + (cl + 4 * n) * 4); buv[n] = *(const LAS f32x4*)(cb + 512 + (cl + 4 * n) * 4); }
        float rs8[2][4];
#pragma unroll
        for (int ai = 0; ai < 2; ++ai)
#pragma unroll
            for (int m = 0; m < 4; ++m) rs8[ai][m] = *(const LAS float*)(cb + 1024 + (ai * HALF + wr * 64 + m * 16 + fr) * 4);
#pragma unroll
        for (int ai = 0; ai < 2; ++ai)
#pragma unroll
            for (int mp = 0; mp < 2; ++mp) { v2u wv[2];
#pragma unroll
                for (int h = 0; h < 2; ++h) { const int m = 2 * mp + h, rl = ai * HALF + wr * 64 + m * 16 + fr; const float rstd = (rl < u.nvalid) ? rs8[ai][m] * (1.0f / (X8S * W8S)) : 0.f;
                    unsigned w[2];
#pragma unroll
                    for (int n = 0; n < 2; ++n) { float o[4];
#pragma unroll
                        for (int j = 0; j < 4; ++j) { float g = acc[ai][0][m][n][j] * rstd + bgv[n][j], up = acc[ai][1][m][n][j] * rstd + buv[n][j];
                            g = fminf(g, 7.0f); up = __builtin_amdgcn_fmed3f(up, -7.0f, 7.0f); o[j] = (g * frcp(1.0f + fexp2(-1.702f * LOG2E * g))) * (up * A8S + A8S); }
                        int w_ = 0; w_ = __builtin_amdgcn_cvt_pk_fp8_f32(o[0], o[1], w_, false); w_ = __builtin_amdgcn_cvt_pk_fp8_f32(o[2], o[3], w_, true); w[n] = (unsigned)w_; }
                    wv[h] = (v2u){w[0], w[1]}; }
                const int rs = ai * HALF + wr * 64 + (2 * mp + odd) * 16 + fr;
                *(u32x4*)(act + (size_t)(u.rowbase + u.pm * 256 + rs) * 1024 + colW) = widen16(wv[0], wv[1]); }
    }
};
struct EpiDown {
    static constexpr bool PERM = true, HAS_PF = true; static constexpr int NE = 8;
    unsigned char* obuf; const float* bdn; const float* gate;
    __device__ __forceinline__ void prefetch(const Unit& u, LAS unsigned char* cb, int lane) const {
        __builtin_amdgcn_global_load_lds((const unsigned*)(bdn + (size_t)u.e * 1024 + u.pn * 256 + lane * 4), (LAS unsigned*)cb, 16, 0, 0);
        __builtin_amdgcn_global_load_lds((const unsigned*)(gate + (size_t)u.e * ECAP + u.pm * 256 + lane * 4), (LAS unsigned*)(cb + 1024), 16, 0, 0);
    }
    __device__ __forceinline__ void operator()(const f32x4 (&acc)[2][2][4][2], const Unit& u, int wr, int wc, int fr, int fq, const LAS unsigned char* cb) const {
        const int cl = wc * 32 + 8 * fq, odd = fq & 1, colW = u.pn * BM + wc * 32 + 8 * (fq & 2);
        f32x4 bv[2][2];
#pragma unroll
        for (int bj = 0; bj < 2; ++bj)
#pragma unroll
            for (int n = 0; n < 2; ++n) bv[bj][n] = *(const LAS f32x4*)(cb + (bj * HALF + cl + 4 * n) * 4);
        float gt8[2][4];
#pragma unroll
        for (int ai = 0; ai < 2; ++ai)
#pragma unroll
            for (int m = 0; m < 4; ++m) gt8[ai][m] = *(const LAS float*)(cb + 1024 + (ai * HALF + wr * 64 + m * 16 + fr) * 4);
#pragma unroll
        for (int ai = 0; ai < 2; ++ai)
#pragma unroll
            for (int mp = 0; mp < 2; ++mp) { v2u wv[2][2];
#pragma unroll
                for (int h = 0; h < 2; ++h) { const int m = 2 * mp + h; const float gt = gt8[ai][m] * O8S;
#pragma unroll
                    for (int bj = 0; bj < 2; ++bj) { const f32x4 v0 = (acc[ai][bj][m][0] * (1.0f / (A8S * W8S)) + bv[bj][0]) * gt, v1 = (acc[ai][bj][m][1] * (1.0f / (A8S * W8S)) + bv[bj][1]) * gt;
                        wv[h][bj] = (v2u){pk4_fp8(v0[0], v0[1], v0[2], v0[3]), pk4_fp8(v1[0], v1[1], v1[2], v1[3])}; } }
                unsigned char* rowp = obuf + (size_t)(u.rowbase + u.pm * 256 + ai * HALF + wr * 64 + (2 * mp + odd) * 16 + fr) * 1024 + colW;
#pragma unroll
                for (int bj = 0; bj < 2; ++bj) *(u32x4*)(rowp + bj * HALF) = widen16(wv[0][bj], wv[1][bj]); }
    }
};
}

#define XB_TMO      128
#define XB_XCNT(j)  (256  + 64 * (j))
#define XB_XSUB(j)  (1280 + 64 * (j))
#define XB_XGEN(j)  (2304 + 64 * (j))
#define XB_TOP      3328
#define XB_TOPGEN   3392
#define XCD_BAR_WORDS 3456
#define XB_SPIN_CAP (1u << 18)
__device__ __forceinline__ unsigned xb_ld(unsigned* p)              { return __hip_atomic_load(p, __ATOMIC_RELAXED, __HIP_MEMORY_SCOPE_AGENT); }
__device__ __forceinline__ unsigned xb_add(unsigned* p, unsigned v) { return __hip_atomic_fetch_add(p, v, __ATOMIC_RELAXED, __HIP_MEMORY_SCOPE_AGENT); }
__device__ __forceinline__ unsigned xb_xcc_id() { return (unsigned)__builtin_amdgcn_s_getreg((3 << 11) | 20) & 0xFu; }
#define XB_SPIN(cond, bar) do { unsigned _sp = 0; while (cond) { __builtin_amdgcn_s_sleep(1); \
    if ((++_sp & 255u) == 0u) { if (xb_ld(&(bar)[XB_TMO])) break; if (_sp > XB_SPIN_CAP) { atomicAdd(&(bar)[XB_TMO], 1u); break; } } } } while (0)
struct XcdBarrier { unsigned* bar; unsigned x; volatile LAS unsigned* st; };
__device__ __forceinline__ XcdBarrier xcd_barrier_post(unsigned* bar, volatile LAS unsigned* st) {
    XcdBarrier b; b.bar = bar; b.x = xb_xcc_id(); b.st = st;
    if (threadIdx.x == 0) (void)xb_add(&bar[XB_XCNT(b.x)], 1u);
    return b;
}
__device__ __forceinline__ void xcd_barrier_complete(unsigned* bar, unsigned x, unsigned& nloc, unsigned& nx) {
    const unsigned G = gridDim.x * gridDim.y * gridDim.z;
    unsigned sum, cnt, mine, sp = 0u;
    for (;;) {
        sum = 0u; cnt = 0u; mine = 0u;
#pragma unroll
        for (unsigned j = 0; j < 16; ++j) { const unsigned c = xb_ld(&bar[XB_XCNT(j)]); sum += c; cnt += (c > 0u) ? 1u : 0u; mine = (j == x) ? c : mine; }
        if (sum == G) break;
        __builtin_amdgcn_s_sleep(1);
        if ((++sp & 255u) == 0u) { if (xb_ld(&bar[XB_TMO])) break; if (sp > XB_SPIN_CAP) { atomicAdd(&bar[XB_TMO], 1u); break; } }
    }
    nloc = mine > 0u ? mine : 1u; nx = cnt > 0u ? cnt : 1u;
}
__device__ __forceinline__ void xcd_barrier(const XcdBarrier& b) {
    asm volatile("s_waitcnt vmcnt(0)" ::: "memory");
    __syncthreads();
    if (threadIdx.x == 0) {
        unsigned* bar = b.bar;
        __builtin_amdgcn_s_waitcnt(0);
        unsigned nloc = b.st[0], nx = b.st[1];
        if (nloc == 0u) { xcd_barrier_complete(bar, b.x, nloc, nx); b.st[0] = nloc; b.st[1] = nx; }
        const unsigned old = xb_add(&bar[XB_XSUB(b.x)], 1u);
        const unsigned gen = old / nloc;
        if (old + 1u == (gen + 1u) * nloc) {
            __builtin_amdgcn_fence(__ATOMIC_RELEASE, "agent");
            asm volatile("s_waitcnt vmcnt(0)" ::: "memory");
            const unsigned og = xb_add(&bar[XB_TOP], 1u);
            const unsigned tg = og / nx;
            if (og + 1u == (tg + 1u) * nx) xb_add(&bar[XB_TOPGEN], 1u);
            else XB_SPIN(xb_ld(&bar[XB_TOPGEN]) == tg, bar);
            __builtin_amdgcn_fence(__ATOMIC_ACQUIRE, "agent");
            xb_add(&bar[XB_XGEN(b.x)], 1u);
            asm volatile("s_waitcnt vmcnt(0)" ::: "memory");
        } else {
            XB_SPIN(xb_ld(&bar[XB_XGEN(b.x)]) == gen, bar);
            __builtin_amdgcn_fence(__ATOMIC_ACQUIRE, "agent");
            asm volatile("s_waitcnt vmcnt(0)" ::: "memory");
        }
    }
    __syncthreads();
}

struct Args { const float* in[15]; float* out; unsigned char* ws; int ph_lo, ph_hi; unsigned char bkt[3][136]; };
struct Frame {
    LAS unsigned char* lds; volatile LAS unsigned* MISC; gu32* ctl;
    int tid, lane, wave, vcu, G;
    unsigned char* ws;
};
__device__ __forceinline__ float wave_sum(float v) {
#pragma unroll
    for (int o = 1; o < 64; o <<= 1) v += __shfl_xor(v, o);
    return v;
}
__device__ __forceinline__ float wave_max(float v) {
#pragma unroll
    for (int o = 1; o < 64; o <<= 1) v = fmaxf(v, __shfl_xor(v, o));
    return v;
}

__device__ __forceinline__ void p0_transpose_item(const float* W, int K, int N, bf16* WT, int kb, int nb, int dst_row0, LAS float* scr, int lane) {
    const int k0 = 64 * kb, n0 = 32 * nb;
    float wv_[32];
#pragma unroll
    for (int i = 0; i < 32; ++i) wv_[i] = __builtin_nontemporal_load(W + (size_t)(k0 + 2 * i + (lane >> 5)) * N + n0 + (lane & 31));
#pragma unroll
    for (int i = 0; i < 32; ++i) scr[(2 * i + (lane >> 5)) * 33 + (lane & 31)] = wv_[i];
    LDS_WAIT(); asm volatile("" ::: "memory");
    const int c = lane & 7;
#pragma unroll
    for (int j = 0; j < 4; ++j) { const int n = (lane >> 3) + 8 * j; const LAS float* s = scr + (8 * c) * 33 + n;
        v4u o; o.x = pk2(s[0 * 33], s[1 * 33]); o.y = pk2(s[2 * 33], s[3 * 33]); o.z = pk2(s[4 * 33], s[5 * 33]); o.w = pk2(s[6 * 33], s[7 * 33]);
        *(GAS v4u*)(WT + (size_t)(dst_row0 + n) * K + k0 + 8 * c) = o; }
    LDS_WAIT(); asm volatile("" ::: "memory");
}
__device__ __forceinline__ void p0_transpose_item_fp8(const float* W, int K, int N, unsigned char* WT, int kb, int nb, int dst_row0, LAS float* scr, int lane) {
    const int k0 = 64 * kb, n0 = 32 * nb;
    float wv_[32];
#pragma unroll
    for (int i = 0; i < 32; ++i) wv_[i] = __builtin_nontemporal_load(W + (size_t)(k0 + 2 * i + (lane >> 5)) * N + n0 + (lane & 31));
#pragma unroll
    for (int i = 0; i < 32; ++i) scr[(2 * i + (lane >> 5)) * 33 + (lane & 31)] = wv_[i];
    LDS_WAIT(); asm volatile("" ::: "memory");
    const int c = lane & 7;
#pragma unroll
    for (int j = 0; j < 4; ++j) { const int n = (lane >> 3) + 8 * j; const LAS float* sp = scr + (8 * c) * 33 + n;
        v2u o; o.x = pk4_fp8(sp[0 * 33] * W8S, sp[1 * 33] * W8S, sp[2 * 33] * W8S, sp[3 * 33] * W8S); o.y = pk4_fp8(sp[4 * 33] * W8S, sp[5 * 33] * W8S, sp[6 * 33] * W8S, sp[7 * 33] * W8S);
        *(GAS v2u*)(WT + (size_t)(dst_row0 + n) * K + k0 + 8 * c) = o; }
    LDS_WAIT(); asm volatile("" ::: "memory");
}
__device__ __forceinline__ void p0_prologue(Frame& F, const Args& a) {
    LAS float* scr = (LAS float*)(F.lds + F.wave * 16384);
    const int gw = F.vcu * NWAVES + F.wave, NGW = F.G * NWAVES;
    const float* w_in = a.in[2]; const float* w_out = a.in[6];
    bf16* WIN = (bf16*)(F.ws + WS_WIN); bf16* WOUT = (bf16*)(F.ws + WS_WOUT);
    constexpr int I_IN = 16 * 112, I_OUT = 16 * 32;
    constexpr int NITEMS = I_IN + I_OUT;
    for (int it = gw; it < NITEMS; it += NGW) {
        int r = it;
        if (r < I_IN) { p0_transpose_item(w_in, D, NPROJ, WIN, r / 112, r % 112, 32 * (r % 112), scr, F.lane); continue; } r -= I_IN;
        p0_transpose_item(w_out, D, D, WOUT, r / 32, r % 32, 32 * (r % 32), scr, F.lane);
    }
    { const int gt = (F.vcu * NWAVES + F.wave) * 64 + F.lane, NT = F.G * NWAVES * 64;
        const float* rw = a.in[8]; const float* nf = a.in[7]; bf16* WR = (bf16*)(F.ws + WS_WR);
        for (int idx = gt; idx < D * NE; idx += NT) { const int k = idx >> 5, e = idx & 31; const float v = rw[idx] * nf[k]; const unsigned hi = f2bf(v); const unsigned lo = f2bf(v - bf2f(hi));
            WR[(size_t)e * 1024 + k] = (bf16)hi; WR[(size_t)(32 + e) * 1024 + k] = (bf16)lo; }
        const float* lbl = a.in[4]; float* LB = (float*)(F.ws + WS_LB);
        for (int c = gt; c < 512; c += NT) LB[c] = frcp(1.0f + __expf(lbl[512 + c] - lbl[c]));
    }
    { const float* x = a.in[0]; const float* nw = a.in[1]; bf16* XN = (bf16*)(F.ws + WS_XN);
        f32x4 wv[4];
#pragma unroll
        for (int j = 0; j < 4; ++j) wv[j] = *((const f32x4*)nw + F.lane + 64 * j);
        for (int m = gw; m < M; m += NGW) {
            const GAS f32x4* xr = (const GAS f32x4*)(x + (size_t)m * D) + F.lane;
            f32x4 v[4]; float s = 0.f;
#pragma unroll
            for (int j = 0; j < 4; ++j) { v[j] = __builtin_nontemporal_load(xr + 64 * j); s += (v[j].x * v[j].x + v[j].y * v[j].y) + (v[j].z * v[j].z + v[j].w * v[j].w); }
            const float rstd = 1.0f / sqrtf(wave_sum(s) * (1.f / D) + RMS_EPS);
            GAS unsigned long long* o8 = (GAS unsigned long long*)(XN + (size_t)m * D) + F.lane;
#pragma unroll
            for (int j = 0; j < 4; ++j) { const f32x4 y = v[j] * rstd * wv[j]; o8[64 * j] = (unsigned long long)pk2(y.x, y.y) | ((unsigned long long)pk2(y.z, y.w) << 32); }
        }
    }
}

typedef float f32x16 __attribute__((ext_vector_type(16)));
typedef short s16x4 __attribute__((ext_vector_type(4)));
typedef short v4i16_t __attribute__((ext_vector_type(4)));
__device__ __forceinline__ s16x4 ds_tr16(const LAS unsigned char* p) { return __builtin_bit_cast(s16x4, __builtin_amdgcn_ds_read_tr16_b64_v4i16((LAS v4i16_t*)p)); }
__device__ __forceinline__ float xhalf_max(float v) { auto rr = __builtin_amdgcn_permlane32_swap(__float_as_uint(v), __float_as_uint(v), false, false); return fmaxf(__uint_as_float(rr[0]), __uint_as_float(rr[1])); }
__device__ __forceinline__ float xhalf_sum(float v) { auto rr = __builtin_amdgcn_permlane32_swap(__float_as_uint(v), __float_as_uint(v), false, false); return __uint_as_float(rr[0]) + __uint_as_float(rr[1]); }
__device__ __forceinline__ void attn_task2(const bf16* QA, const bf16* KA, const bf16* VA, bf16* RUN, float* LRUN, bf16* MIX, const int mode, const LAS float* tbl, LAS unsigned char* vt,
                                           const int b, const int h, const int dil, const int pos0, const int lane) {
    const int q = lane & 31, hi = lane >> 5;
    const size_t rowb = (size_t)b * SEQ;
    bf16x8 qr[2][4];
    const bf16* Qb = QA + rowb * 512 + h * 64; const bf16* Kb = KA + rowb * 512 + h * 64; const bf16* Vb = VA + rowb * 512 + h * 64;
#pragma unroll
    for (int t = 0; t < 2; ++t) { const unsigned qo = (unsigned)((pos0 + dil * (32 * t + q)) * 512 + 8 * hi);
#pragma unroll
        for (int d0 = 0; d0 < 4; ++d0) qr[t][d0] = *(const bf16x8*)(Qb + qo + 16 * d0); }
    int c0 = 0; while (pos0 + dil * (32 * c0 - 128) < 0) ++c0;
    float m[2] = {-1e30f, -1e30f}, l[2] = {0.f, 0.f}; f32x16 o0[2], o1[2];
#pragma unroll
    for (int t = 0; t < 2; ++t)
#pragma unroll
        for (int r = 0; r < 16; ++r) { o0[t][r] = 0.f; o1[t][r] = 0.f; }
    const int trrow = (lane & 15) >> 2, trcol = 16 * ((lane >> 4) & 1) + 4 * (lane & 3);
    v4u kr[4], vn[4]; bf16x8 kf[4];
    LAS unsigned char* kt = vt + 5120;
    const unsigned ro0 = (unsigned)(dil * (lane >> 3) * 512 + 8 * (lane & 7));
#define ATT_TBASE(cc, i_) ((pos0 + dil * (32 * ((cc) < c0 ? c0 : (cc)) - 128 + 8 * (i_))) * 512)
#define ATT_LOADK(cc) do { _Pragma("unroll") for (int i = 0; i < 4; ++i) kr[i] = *(const v4u*)(Kb + ATT_TBASE(cc, i) + ro0); } while (0)
#define ATT_LOADV(cc) do { _Pragma("unroll") for (int i = 0; i < 4; ++i) vn[i] = *(const v4u*)(Vb + ATT_TBASE(cc, i) + ro0); } while (0)
    ATT_LOADK(0);
#pragma unroll
    for (int c = 0; c < 6; ++c) {
        ATT_LOADV(c);
#pragma unroll
        for (int i = 0; i < 4; ++i) { const int id = lane + 64 * i; *(LAS v4u*)(kt + (id >> 3) * 144 + (id & 7) * 16) = kr[i]; }
        if (c + 1 < 6) ATT_LOADK(c + 1);
#pragma unroll
        for (int d0 = 0; d0 < 4; ++d0) kf[d0] = *(const LAS bf16x8*)(kt + q * 144 + (16 * d0 + 8 * hi) * 2);
        if (c >= c0) {
        bool staged = false;
#pragma unroll
        for (int t = 0; t < 2; ++t) { const int ct = c - t;
            if (ct >= 0 && ct <= 4) {
                f32x16 s;
#pragma unroll
                for (int g4 = 0; g4 < 4; ++g4) { const f32x4 bq = *(const LAS f32x4*)(tbl + ((ct * 4 + g4) * 64 + lane) * 4); s[4 * g4] = bq.x; s[4 * g4 + 1] = bq.y; s[4 * g4 + 2] = bq.z; s[4 * g4 + 3] = bq.w; }
#pragma unroll
                for (int d0 = 0; d0 < 4; ++d0) s = __builtin_amdgcn_mfma_f32_32x32x16_bf16(kf[d0], qr[t][d0], s, 0, 0, 0);
                float mx = -1e30f;
#pragma unroll
                for (int r = 0; r < 16; ++r) mx = fmaxf(mx, s[r]);
                mx = xhalf_max(mx);
                if (__any(mx > m[t] + 8.0f)) {
                    const float mn = fmaxf(m[t], mx), alpha = fexp2(m[t] - mn); m[t] = mn; l[t] *= alpha;
#pragma unroll
                    for (int r = 0; r < 16; ++r) { o0[t][r] *= alpha; o1[t][r] *= alpha; } }
                const float mref = m[t];
                float ps = 0.f;
#pragma unroll
                for (int r = 0; r < 16; ++r) { s[r] = fexp2(s[r] - mref); ps += s[r]; }
                l[t] += ps;
                if (!staged) { staged = true;
#pragma unroll
                    for (int i = 0; i < 4; ++i) { const int id = lane + 64 * i; *(LAS v4u*)(vt + (id >> 3) * 128 + (id & 7) * 16) = vn[i]; }
                }
#pragma unroll
                for (int ks = 0; ks < 2; ++ks) {
                    v4u pw; pw.x = pg8::cvt_pk_bf16(s[8 * ks], s[8 * ks + 1]); pw.y = pg8::cvt_pk_bf16(s[8 * ks + 2], s[8 * ks + 3]); pw.z = pg8::cvt_pk_bf16(s[8 * ks + 4], s[8 * ks + 5]); pw.w = pg8::cvt_pk_bf16(s[8 * ks + 6], s[8 * ks + 7]);
                    const bf16x8 pf = __builtin_bit_cast(bf16x8, pw);
                    const LAS unsigned char* va = vt + (16 * ks + 4 * hi + trrow) * 128 + trcol * 2;
                    s16x4 l0 = ds_tr16(va), h0 = ds_tr16(va + 8 * 128), l1 = ds_tr16(va + 64), h1 = ds_tr16(va + 64 + 8 * 128);
                    asm volatile("s_waitcnt lgkmcnt(0)" : "+v"(l0), "+v"(h0), "+v"(l1), "+v"(h1) :: "memory");
                    o0[t] = __builtin_amdgcn_mfma_f32_32x32x16_bf16((bf16x8){l0[0], l0[1], l0[2], l0[3], h0[0], h0[1], h0[2], h0[3]}, pf, o0[t], 0, 0, 0);
                    o1[t] = __builtin_amdgcn_mfma_f32_32x32x16_bf16((bf16x8){l1[0], l1[1], l1[2], l1[3], h1[0], h1[1], h1[2], h1[3]}, pf, o1[t], 0, 0, 0);
                }
            } }
        }
    }
#undef ATT_LOADK
#undef ATT_LOADV
#undef ATT_TBASE
    bf16* RUNb = RUN + rowb * 512 + h * 64; float* LRUNb = LRUN + rowb * 8 + h; bf16* MIXb = MIX + rowb * 1024 + h * 64;
#pragma unroll
    for (int t = 0; t < 2; ++t) {
        const float lt = xhalf_sum(l[t]); const float inv = frcp(lt);
#pragma unroll
        for (int g = 0; g < 4; ++g) {
            v2u w0, w1;
            w0.x = pg8::cvt_pk_bf16(o0[t][4 * g] * inv, o0[t][4 * g + 1] * inv); w0.y = pg8::cvt_pk_bf16(o0[t][4 * g + 2] * inv, o0[t][4 * g + 3] * inv);
            w1.x = pg8::cvt_pk_bf16(o1[t][4 * g] * inv, o1[t][4 * g + 1] * inv); w1.y = pg8::cvt_pk_bf16(o1[t][4 * g + 2] * inv, o1[t][4 * g + 3] * inv);
            *(LAS v2u*)(vt + q * 144 + (8 * g + 4 * hi) * 2) = w0; *(LAS v2u*)(vt + q * 144 + (32 + 8 * g + 4 * hi) * 2) = w1;
        }
        if (hi == 0) *(LAS float*)(vt + 4608 + q * 4) = m[t] + __builtin_amdgcn_logf(lt);
        v4u rv[4]; float rl[4];
        if (mode > 0) {
#pragma unroll
            for (int i = 0; i < 4; ++i) { const int row = 8 * i + (lane >> 3), ch = lane & 7; const unsigned ro = (unsigned)(pos0 + dil * (32 * t + row));
                rv[i] = *(const v4u*)(RUNb + (unsigned)(ro * 512 + 8 * ch)); rl[i] = LRUNb[(unsigned)(ro * 8)]; } }
        asm volatile("s_waitcnt lgkmcnt(0)" ::: "memory");
#pragma unroll
        for (int i = 0; i < 4; ++i) { const int row = 8 * i + (lane >> 3), ch = lane & 7; const unsigned ro = (unsigned)(pos0 + dil * (32 * t + row));
            v4u v = *(const LAS v4u*)(vt + row * 144 + ch * 16); float ln = *(const LAS float*)(vt + 4608 + row * 4);
            if (mode > 0) { const float mx = fmaxf(ln, rl[i]), wn0 = fexp2(ln - mx), wr0 = fexp2(rl[i] - mx), sw = wn0 + wr0, iv = frcp(sw), wn = wn0 * iv, wr = wr0 * iv; const v4u r = rv[i];
                v.x = pk2(wn * bflo(v.x) + wr * bflo(r.x), wn * bfhi(v.x) + wr * bfhi(r.x)); v.y = pk2(wn * bflo(v.y) + wr * bflo(r.y), wn * bfhi(v.y) + wr * bfhi(r.y));
                v.z = pk2(wn * bflo(v.z) + wr * bflo(r.z), wn * bfhi(v.z) + wr * bfhi(r.z)); v.w = pk2(wn * bflo(v.w) + wr * bflo(r.w), wn * bfhi(v.w) + wr * bfhi(r.w));
                ln = mx + __builtin_amdgcn_logf(sw); }
            if (mode < 2) { *(v4u*)(RUNb + (unsigned)(ro * 512 + 8 * ch)) = v; if (ch == 0) LRUNb[(unsigned)(ro * 8)] = ln; }
            else *(v4u*)(MIXb + (unsigned)(ro * 1024 + 8 * ch)) = v; }
        asm volatile("s_waitcnt lgkmcnt(0)" ::: "memory");
    }
}
__device__ __forceinline__ void attn_mfma(Frame& F, const Args& a, const int rank, const int nblk) {
    LAS float* tbl = (LAS float*)F.lds;
    LAS float* xtb = (LAS float*)(F.lds + 4096 + NWAVES * 9728);
    LAS unsigned char* vt = F.lds + 4096 + F.wave * 9728;
    const float* rel = a.in[3];
    const bf16* QA = (const bf16*)(F.ws + WS_PROJ); const bf16* KA = QA + PROJ_STRIDE; const bf16* VA = QA + 2 * PROJ_STRIDE;
    bf16* ATTP = (bf16*)(F.ws + WS_ATTP); float* LSE = (float*)(F.ws + WS_LSE); bf16* MIX = (bf16*)(F.ws + WS_MIX);
    for (int u = rank; u < 256; u += nblk) {
        const int bh = u >> 2, span = u & 3, b = bh >> 3, h = bh & 7, P0 = span * 1024;
        for (int idx = F.tid; idx < 3 * 192; idx += NWAVES * 64) { const int p = idx / 192, jj = idx % 192 - 32;
            tbl[idx] = (jj >= 0 && jj <= 128) ? rel[(int)a.bkt[p][jj] * 8 + h] * LOG2E : -1e30f; }
        __syncthreads();
        for (int idx = F.tid; idx < 3 * 5 * 4 * 64; idx += NWAVES * 64) { const int ln = idx & 63, g4 = (idx >> 6) & 3, ct = (idx >> 8) % 5, p = idx / 1280, q_ = ln & 31, hi_ = ln >> 5;
            f32x4 v;
#pragma unroll
            for (int e = 0; e < 4; ++e) { const int r = 4 * g4 + e, kv = (r & 3) + 8 * (r >> 2) + 4 * hi_; v[e] = tbl[p * 192 + 160 - 32 * ct + q_ - kv]; }
            *(LAS f32x4*)(xtb + (size_t)idx * 4) = v; }
        __syncthreads();
#pragma unroll 1
        for (int p = 0; p < 3; ++p) {
            const int dil = (p == 0) ? 1 : (p == 1 ? 4 : 16), ppr = 16 / dil;
            for (int kk = 0; kk < 2; ++kk) { const int ix = (F.wave + 8 * kk) , r = ix / ppr, j = ix % ppr;
                attn_task2(QA, KA, VA, ATTP, LSE, MIX, p, xtb + p * 5120, vt, b, h, dil, P0 + r + dil * 64 * j, F.lane); }
            VM_WAIT();
            __syncthreads();
        }
    }
}

constexpr int HPB = 272;
constexpr int H_QE = 0, H_KD = H_QE + 64 * HPB, H_KS = H_KD + 64 * HPB, H_I = H_KS + 64 * HPB, H_QJ = H_I + 64 * HPB, H_AB = H_QJ + 160 * HPB, H_TQ = H_AB + 64 * 144, H_EL = H_TQ + 8192;
constexpr int H_O = RING_BYTES;
static_assert(H_EL + 512 <= RING_BYTES && H_O + 64 * HPB <= TAB_OFF, "hgrn LDS map");
constexpr size_t WS_US = WS_HO, WS_DV = WS_HO + 32 * MiB;
__device__ __forceinline__ f32x4 exp4(f32x4 x) { return (f32x4){fexp2(x.x * LOG2E), fexp2(x.y * LOG2E), fexp2(x.z * LOG2E), fexp2(x.w * LOG2E)}; }
__device__ __forceinline__ v2u pack4(f32x4 v) { v2u r; r.x = pg8::cvt_pk_bf16(v.x, v.y); r.y = pg8::cvt_pk_bf16(v.z, v.w); return r; }
__device__ __forceinline__ f32x4 unpack4(v2u w) { return (f32x4){bflo(w.x), bfhi(w.x), bflo(w.y), bfhi(w.y)}; }
constexpr int G_T0 = 0, G_TSZ = 3 * 64 * HPB, G_TQ = 2 * G_TSZ, G_ET = G_TQ + 2 * 8192, G_END = G_ET + 2 * 2048;
static_assert(G_END <= RING_BYTES, "hgrn2 LDS map");
constexpr int H_NSC = 8, H_CPS = SEQ / 64 / H_NSC;
template <int MODE>
__device__ __forceinline__ void hgrn_units2(Frame& F, const Args& a, const int rank, const int nblk) {
    const bf16* QH = (const bf16*)(F.ws + WS_PROJ) + 3 * PROJ_STRIDE; const bf16* FA = QH + PROJ_STRIDE; const bf16* IH = QH + 2 * PROJ_STRIDE; const bf16* GH = QH + 3 * PROJ_STRIDE;
    float* US = (float*)(F.ws + WS_US); float* DV = (float*)(F.ws + WS_DV); bf16* MIX = (bf16*)(F.ws + WS_MIX);
    LAS unsigned char* L = F.lds;
    const int tid = F.tid, lane = F.lane, w = F.wave, l16 = lane & 15, g = lane >> 4;
    const int kq = tid & 31, tq = tid >> 5, I = tq >> 2;
    for (int u = rank; u < BATCH * HH * H_NSC; u += nblk) {
        const int bh = u & 31, sc = u >> 5, b = bh >> 2, h = bh & 3, unit = bh * H_NSC + sc;
        f32x4 S[8];
        if (MODE == 1) {
#pragma unroll
            for (int kt = 0; kt < 8; ++kt) S[kt] = *(const f32x4*)(US + (size_t)unit * 16384 + w * 2048 + kt * 256 + lane * 4);
        } else {
#pragma unroll
            for (int kt = 0; kt < 8; ++kt) S[kt] = (f32x4){0.f, 0.f, 0.f, 0.f};
        }
        f32x4 sumlast = {0.f, 0.f, 0.f, 0.f};
        const size_t base = ((size_t)b * SEQ + 64 * H_CPS * sc) * 512 + h * 128;
        v2u na[4], nq[4], ni[4];
        f32x4 loc[4], kkv[4], qv[4]; v2u ri[4];
#define G_LOAD(cc) do { _Pragma("unroll") for (int j = 0; j < 4; ++j) { const size_t off_ = base + (size_t)(64 * (cc) + 4 * tq + j) * 512 + 4 * kq; \
            na[j] = __builtin_nontemporal_load((const v2u*)(FA + off_)); if (MODE == 1) nq[j] = __builtin_nontemporal_load((const v2u*)(QH + off_)); ni[j] = __builtin_nontemporal_load((const v2u*)(IH + off_)); } } while (0)
#define G_STAGE_A(buf) do { f32x4 av_[4]; _Pragma("unroll") for (int j = 0; j < 4; ++j) { av_[j] = unpack4(na[j]); if (MODE == 1) qv[j] = unpack4(nq[j]); ri[j] = ni[j]; \
                kkv[j] = (f32x4){1.f, 1.f, 1.f, 1.f} - exp4(av_[j]); } \
            loc[0] = av_[0]; loc[1] = loc[0] + av_[1]; loc[2] = loc[1] + av_[2]; loc[3] = loc[2] + av_[3]; \
            *(LAS f32x4*)(L + G_TQ + (buf) * 8192 + (tq * 128 + 4 * kq) * 4) = loc[3]; } while (0)
#define G_STAGE_B(buf) do { LAS unsigned char* T_ = L + (buf) * G_TSZ; const LAS unsigned char* Q_ = L + G_TQ + (buf) * 8192; \
            f32x4 mypre = {0.f, 0.f, 0.f, 0.f}, tot = mypre; \
            _Pragma("unroll") for (int i = 0; i < 4; ++i) { const f32x4 x_ = *(const LAS f32x4*)(Q_ + ((4 * I + i) * 128 + 4 * kq) * 4); mypre = ((4 * I + i) < tq) ? mypre + x_ : mypre; tot += x_; } \
            if ((tq & 3) == 0) *(LAS f32x4*)(L + G_ET + (buf) * 2048 + (I * 128 + 4 * kq) * 4) = exp4(tot); \
            if (MODE == 0 && tq == 0) { _Pragma("unroll") for (int i = 0; i < 16; ++i) sumlast += *(const LAS f32x4*)(Q_ + (i * 128 + 4 * kq) * 4); } \
            _Pragma("unroll") for (int j = 0; j < 4; ++j) { const int t_ = 4 * tq + j; const f32x4 E_ = exp4(mypre + loc[j]); \
                f32x4 R_; R_.x = fminf(frcp(E_.x), 5.0e34f); R_.y = fminf(frcp(E_.y), 5.0e34f); R_.z = fminf(frcp(E_.z), 5.0e34f); R_.w = fminf(frcp(E_.w), 5.0e34f); \
                if (MODE == 1) *(LAS v2u*)(T_ + t_ * HPB + 8 * kq) = pack4(qv[j] * E_); \
                *(LAS v2u*)(T_ + 64 * HPB + t_ * HPB + 8 * kq) = pack4(kkv[j] * R_); \
                *(LAS v2u*)(T_ + 128 * HPB + t_ * HPB + 8 * kq) = ri[j]; } } while (0)
        G_LOAD(0); G_STAGE_A(0); G_LOAD(1);
        __syncthreads();
        G_STAGE_B(0); G_STAGE_A(1);
        __syncthreads();
        for (int c = 0; c < H_CPS; ++c) {
            if (c + 2 < H_CPS) G_LOAD(c + 2);
            if (c + 1 < H_CPS) G_STAGE_B((c + 1) & 1);
            { const LAS unsigned char* T = L + (c & 1) * G_TSZ; const LAS unsigned char* TK = T + 64 * HPB; const LAS unsigned char* TI = T + 128 * HPB; const LAS unsigned char* ET = L + G_ET + (c & 1) * 2048;
#pragma unroll
              for (int I2 = 0; I2 < 4; ++I2) { const int r0 = 16 * I2;
                s16x4 ib = ds_tr16(TI + (r0 + 4 * g + (l16 >> 2)) * HPB + (16 * w + 4 * (l16 & 3)) * 2);
                s16x4 kk_[8];
#pragma unroll
                for (int kt = 0; kt < 8; ++kt) kk_[kt] = ds_tr16(TK + (r0 + 4 * g + (l16 >> 2)) * HPB + (16 * kt + 4 * (l16 & 3)) * 2);
                asm volatile("s_waitcnt lgkmcnt(0)" : "+v"(ib), "+v"(kk_[0]), "+v"(kk_[1]), "+v"(kk_[2]), "+v"(kk_[3]), "+v"(kk_[4]), "+v"(kk_[5]), "+v"(kk_[6]), "+v"(kk_[7]) :: "memory");
                const bf16x8 IB = (bf16x8){ib[0], ib[1], ib[2], ib[3], 0, 0, 0, 0};
                if (MODE == 1) {
                    f32x4 o = {0.f, 0.f, 0.f, 0.f}, AT = {0.f, 0.f, 0.f, 0.f};
#pragma unroll
                    for (int k4 = 0; k4 < 4; ++k4) {
                        const LAS unsigned char* qp = T + (r0 + l16) * HPB + (32 * k4 + 4 * g) * 2; const LAS unsigned char* kp = TK + (r0 + l16) * HPB + (32 * k4 + 4 * g) * 2;
                        const v2u ql = *(const LAS v2u*)qp, qh = *(const LAS v2u*)(qp + 32), kl = *(const LAS v2u*)kp, kh = *(const LAS v2u*)(kp + 32);
                        const bf16x8 Aq = __builtin_bit_cast(bf16x8, (v4u){ql.x, ql.y, qh.x, qh.y}), Kr = __builtin_bit_cast(bf16x8, (v4u){kl.x, kl.y, kh.x, kh.y});
                        v4u sw; { const v2u lo = pack4(S[2 * k4]), hh = pack4(S[2 * k4 + 1]); sw.x = lo.x; sw.y = lo.y; sw.z = hh.x; sw.w = hh.y; }
                        o = __builtin_amdgcn_mfma_f32_16x16x32_bf16(Aq, __builtin_bit_cast(bf16x8, sw), o, 0, 0, 0);
                        AT = __builtin_amdgcn_mfma_f32_16x16x32_bf16(Kr, Aq, AT, 0, 0, 0); }
#pragma unroll
                    for (int j = 0; j < 4; ++j) AT[j] = (4 * g + j <= l16) ? AT[j] : 0.f;
                    const v2u ap = pack4(AT);
                    o = __builtin_amdgcn_mfma_f32_16x16x32_bf16(__builtin_bit_cast(bf16x8, (v4u){ap.x, ap.y, 0u, 0u}), IB, o, 0, 0, 0);
#pragma unroll
                    for (int j = 0; j < 4; ++j) *(LAS bf16*)(L + H_O + (r0 + 4 * g + j) * HPB + (16 * w + l16) * 2) = (bf16)f2bf(o[j]);
                }
#pragma unroll
                for (int kt = 0; kt < 8; ++kt) {
                    S[kt] = __builtin_amdgcn_mfma_f32_16x16x32_bf16((bf16x8){kk_[kt][0], kk_[kt][1], kk_[kt][2], kk_[kt][3], 0, 0, 0, 0}, IB, S[kt], 0, 0, 0);
                    S[kt] = S[kt] * *(const LAS f32x4*)(ET + (I2 * 128 + 16 * kt + 4 * g) * 4); }
              } }
            if (c + 2 < H_CPS) G_STAGE_A(c & 1);
            __syncthreads();
            if (MODE == 1) {
                const float* nw = a.in[5];
#pragma unroll
                for (int it = 0; it < 2; ++it) { const int item = tid + 512 * it, t = item >> 4, v8 = (item & 15) * 8;
                    const v4u ow = *(const LAS v4u*)(L + H_O + t * HPB + v8 * 2);
                    const f32x4 o0 = {bflo(ow.x), bfhi(ow.x), bflo(ow.y), bfhi(ow.y)}, o1 = {bflo(ow.z), bfhi(ow.z), bflo(ow.w), bfhi(ow.w)};
                    float ss = (o0.x * o0.x + o0.y * o0.y) + (o0.z * o0.z + o0.w * o0.w) + (o1.x * o1.x + o1.y * o1.y) + (o1.z * o1.z + o1.w * o1.w);
                    ss += __shfl_xor(ss, 1); ss += __shfl_xor(ss, 2); ss += __shfl_xor(ss, 4); ss += __shfl_xor(ss, 8);
                    const float rstd = 1.0f / sqrtf(ss * (1.f / 128.f) + RMS_EPS);
                    const size_t row = (size_t)b * SEQ + 64 * H_CPS * sc + 64 * c + t;
                    const v4u gw = __builtin_nontemporal_load((const v4u*)(GH + row * 512 + h * 128 + v8));
                    const f32x4 w0 = *(const f32x4*)(nw + v8), w1 = *(const f32x4*)(nw + v8 + 4);
                    const f32x4 y0 = o0 * rstd * w0, y1 = o1 * rstd * w1;
                    v4u o; o.x = pk2(y0.x * bflo(gw.x), y0.y * bfhi(gw.x)); o.y = pk2(y0.z * bflo(gw.y), y0.w * bfhi(gw.y)); o.z = pk2(y1.x * bflo(gw.z), y1.y * bfhi(gw.z)); o.w = pk2(y1.z * bflo(gw.w), y1.w * bfhi(gw.w));
                    *(v4u*)(MIX + row * 1024 + 512 + h * 128 + v8) = o; }
                __syncthreads();
            }
        }
#undef G_LOAD
#undef G_STAGE_A
#undef G_STAGE_B
        if (MODE == 0) {
#pragma unroll
            for (int kt = 0; kt < 8; ++kt) *(f32x4*)(US + (size_t)unit * 16384 + w * 2048 + kt * 256 + lane * 4) = S[kt];
            if (tq == 0) *(f32x4*)(DV + (size_t)unit * 128 + 4 * kq) = exp4(sumlast);
        }
        __syncthreads();
    }
}

__device__ __forceinline__ void hgrn_scan(Frame& F) {
    float* US = (float*)(F.ws + WS_US); const float* DV = (const float*)(F.ws + WS_DV);
    const int gt = (F.vcu * NWAVES + F.wave) * 64 + F.lane, NT = F.G * NWAVES * 64;
    for (int idx = gt; idx < 32 * 4096; idx += NT) { const int bh = idx >> 12, r = idx & 4095, kt = (r & 511) >> 6, ln = r & 63, kb = 16 * kt + 4 * (ln >> 4);
        f32x4 run = {0.f, 0.f, 0.f, 0.f};
#pragma unroll 4
        for (int sc = 0; sc < H_NSC; ++sc) { const size_t unit = (size_t)bh * H_NSC + sc; float* p = US + unit * 16384 + (size_t)r * 4;
            const f32x4 uu = __builtin_nontemporal_load((const f32x4*)p), d = *(const f32x4*)(DV + unit * 128 + kb);
            *(f32x4*)p = run; run = d * run + uu; }
    }
}

constexpr int CV_GU = NE * 16 * 64, CV_DN = NE * 16 * 32;
__device__ __forceinline__ int dn_early(const int G) { const int n = 64 * G; return n < CV_DN ? n : CV_DN; }
__device__ __forceinline__ void moe_dn_item_fp8(Frame& F, const Args& a, const int it, LAS float* scr) {
    const int e = it / (16 * 32), q = it % (16 * 32);
    p0_transpose_item_fp8(a.in[12] + (size_t)e * 1024 * 1024, D, D, F.ws + WS_WDN + (size_t)e * 1024 * 1024, q / 32, q % 32, 32 * (q % 32), scr, F.lane);
}
#define CV_LOAD(w, it_) do { const int e_ = (it_) / 512, q_ = (it_) % 512; const float* s_ = a.in[12] + (size_t)e_ * 1024 * 1024 + (size_t)(64 * (q_ / 32) + (lane >> 5)) * 1024 + 32 * (q_ % 32) + (lane & 31); \
        _Pragma("unroll") for (int i = 0; i < 32; ++i) w[i] = __builtin_nontemporal_load(s_ + (size_t)(2 * i) * 1024); } while (0)
#define CV_FINISH(w, it_) do { const int e_ = (it_) / 512, q_ = (it_) % 512; unsigned char* d_ = F.ws + WS_WDN + (size_t)e_ * 1024 * 1024 + (size_t)(32 * (q_ % 32)) * 1024 + 64 * (q_ / 32); \
        _Pragma("unroll") for (int i = 0; i < 32; ++i) scr[(2 * i + (lane >> 5)) * 33 + (lane & 31)] = w[i]; \
        LDS_WAIT(); asm volatile("" ::: "memory"); \
        _Pragma("unroll") for (int j = 0; j < 4; ++j) { const int n = (lane >> 3) + 8 * j; const LAS float* sp = scr + (8 * (lane & 7)) * 33 + n; \
            v2u o; o.x = pk4_fp8(sp[0 * 33] * W8S, sp[1 * 33] * W8S, sp[2 * 33] * W8S, sp[3 * 33] * W8S); o.y = pk4_fp8(sp[4 * 33] * W8S, sp[5 * 33] * W8S, sp[6 * 33] * W8S, sp[7 * 33] * W8S); \
            *(GAS v2u*)(d_ + (size_t)n * 1024 + 8 * (lane & 7)) = o; } \
        LDS_WAIT(); asm volatile("" ::: "memory"); } while (0)
__device__ __forceinline__ void moe_dn_filler(Frame& F, const Args& a, const int ph, const bool before) {
    const int G = F.G, c = (int)blockIdx.x, g = (c >> 3) % 5, lane = F.lane;
    LAS float* scr = (LAS float*)(F.lds + F.wave * 16384);
    const int base = ph * 32 * G + c * NWAVES + F.wave, st = NWAVES * G;
    int k = before ? 0 : g, k1 = before ? g : 4;
    while (k1 > k && base + (k1 - 1) * st >= CV_DN) --k1;
    if (k >= k1) return;
    float wa[32], wb[32];
    CV_LOAD(wa, base + k * st);
    for (;;) {
        const bool hb = k + 1 < k1;
        if (hb) CV_LOAD(wb, base + (k + 1) * st);
        CV_FINISH(wa, base + k * st);
        if (!hb) break;
        const bool ha = k + 2 < k1;
        if (ha) CV_LOAD(wa, base + (k + 2) * st);
        CV_FINISH(wb, base + (k + 1) * st);
        if (!ha) break;
        k += 2;
    }
}
#undef CV_LOAD
#undef CV_FINISH
__device__ __forceinline__ void moe_weights_to_fp8(Frame& F, const Args& a) {
    LAS float* scr = (LAS float*)(F.lds + F.wave * 16384);
    const int gw = F.vcu * NWAVES + F.wave, NGW = F.G * NWAVES, early = dn_early(F.G);
    const float* w_gu = a.in[10]; unsigned char* WGU = F.ws + WS_WGU;
    constexpr int I_GU1 = 16 * 64;
    for (int it = gw; it < CV_GU + CV_DN - early; it += NGW) {
        if (it < CV_GU) { const int e = it / I_GU1, q = it % I_GU1, kb = q / 64, nb = q % 64, n0 = 32 * nb;
            const int dst = (n0 < 1024) ? (256 * (n0 >> 7) + (n0 & 127)) : (256 * ((n0 - 1024) >> 7) + 128 + ((n0 - 1024) & 127));
            p0_transpose_item_fp8(w_gu + (size_t)e * 1024 * 2048, D, 2048, WGU + (size_t)e * 2048 * 1024, kb, nb, dst, scr, F.lane); continue; }
        moe_dn_item_fp8(F, a, it - CV_GU + early, scr);
    }
}
__device__ __forceinline__ int moe_pos(const int G) { const int c = (int)blockIdx.x, k = c >> 3; return (G % 16 == 0) ? (k & 1) * (G / 2) + (k >> 1) * 8 + (c & 7) : c; }
__device__ __forceinline__ void moe_stagger(Frame& F) {
    const int T = ((const LAS int*)(F.lds + CNT_OFF))[33], G = F.G, rem = T % G, i = moe_pos(G) - rem;
    if (rem == 0 || i < 0) return;
    const int slack = G - rem, h = (G / 2 < slack) ? G / 2 : slack;
    if (((i + 1) * h) / slack != (i * h) / slack) { __builtin_amdgcn_s_sleep(127); __builtin_amdgcn_s_sleep(127); __builtin_amdgcn_s_sleep(74); }
}
__device__ __forceinline__ void router_phase(Frame& F, const Args& a) {
    LAS int* lcnt = (LAS int*)F.lds;
    LAS int* lbase = lcnt + 32;
    LAS float* lg = (LAS float*)(F.lds + 1024) + F.wave * (16 * 33 + 16);
    const bf16* H = (const bf16*)(F.ws + WS_HB); const float* nf = a.in[7]; const float* rb = a.in[9];
    const bf16* WR = (const bf16*)(F.ws + WS_WR); unsigned char* XQ = F.ws + WS_XN;
    int* TOK = (int*)(F.ws + WS_TOK); int* SLOT = (int*)(F.ws + WS_SLOT); float* GATE = (float*)(F.ws + WS_GATE); float* RS = (float*)(F.ws + WS_RS);
    const int lane = F.lane, r16 = lane & 15, g = lane >> 4;
    LAS unsigned char* wl = F.lds + 18432;
    for (int c = F.tid; c < 64 * 128; c += NWAVES * 64) { const int row = c >> 7, ch = c & 127; *(LAS v4u*)(wl + row * 2064 + ch * 16) = *(const v4u*)(WR + (size_t)row * 1024 + ch * 8); }
    const LAS unsigned char* wlane = wl + r16 * 2064 + g * 16;
    for (int tb = blockIdx.x; tb < M / 128; tb += F.G) {
        if (F.tid < 32) lcnt[F.tid] = 0;
        __syncthreads();
        const int t0 = tb * 128 + F.wave * 16;
        const bf16* hp = H + (size_t)(t0 + r16) * D + 8 * g;
        unsigned char* xo = XQ + (size_t)(t0 + r16) * D + 8 * g;
        f32x4 acc0 = {0.f, 0.f, 0.f, 0.f}, acc1 = {0.f, 0.f, 0.f, 0.f}; float ssq = 0.f;
#pragma unroll 4
        for (int s2 = 0; s2 < 32; s2 += 2) { v2u q8[2];
#pragma unroll
          for (int hh = 0; hh < 2; ++hh) { const int s = s2 + hh;
            const v4u xw = __builtin_nontemporal_load((const v4u*)(hp + 32 * s));
            const f32x4 x0 = {bflo(xw.x), bfhi(xw.x), bflo(xw.y), bfhi(xw.y)}, x1 = {bflo(xw.z), bfhi(xw.z), bflo(xw.w), bfhi(xw.w)};
            const f32x4 w0 = *(const f32x4*)(nf + 32 * s + 8 * g), w1 = *(const f32x4*)(nf + 32 * s + 8 * g + 4);
            ssq += (x0.x * x0.x + x0.y * x0.y) + (x0.z * x0.z + x0.w * x0.w) + (x1.x * x1.x + x1.y * x1.y) + (x1.z * x1.z + x1.w * x1.w);
            const f32x4 v0 = x0 * w0, v1 = x1 * w1;
            v4u ah, al;
            ah.x = pg8::cvt_pk_bf16(v0[0], v0[1]); ah.y = pg8::cvt_pk_bf16(v0[2], v0[3]); ah.z = pg8::cvt_pk_bf16(v1[0], v1[1]); ah.w = pg8::cvt_pk_bf16(v1[2], v1[3]);
            al.x = pg8::cvt_pk_bf16(v0[0] - bflo(ah.x), v0[1] - bfhi(ah.x)); al.y = pg8::cvt_pk_bf16(v0[2] - bflo(ah.y), v0[3] - bfhi(ah.y));
            al.z = pg8::cvt_pk_bf16(v1[0] - bflo(ah.z), v1[1] - bfhi(ah.z)); al.w = pg8::cvt_pk_bf16(v1[2] - bflo(ah.w), v1[3] - bfhi(ah.w));
            q8[hh] = (v2u){pk4_fp8(v0[0] * X8S, v0[1] * X8S, v0[2] * X8S, v0[3] * X8S), pk4_fp8(v1[0] * X8S, v1[1] * X8S, v1[2] * X8S, v1[3] * X8S)};
            const bf16x8 fah = __builtin_bit_cast(bf16x8, ah), fal = __builtin_bit_cast(bf16x8, al);
            const bf16x8 bh0 = *(const LAS bf16x8*)(wlane + 64 * s), bh1 = *(const LAS bf16x8*)(wlane + 16 * 2064 + 64 * s);
            const bf16x8 bl0 = *(const LAS bf16x8*)(wlane + 32 * 2064 + 64 * s), bl1 = *(const LAS bf16x8*)(wlane + 48 * 2064 + 64 * s);
            acc0 = __builtin_amdgcn_mfma_f32_16x16x32_bf16(fah, bh0, acc0, 0, 0, 0); acc0 = __builtin_amdgcn_mfma_f32_16x16x32_bf16(fal, bh0, acc0, 0, 0, 0); acc0 = __builtin_amdgcn_mfma_f32_16x16x32_bf16(fah, bl0, acc0, 0, 0, 0);
            acc1 = __builtin_amdgcn_mfma_f32_16x16x32_bf16(fah, bh1, acc1, 0, 0, 0); acc1 = __builtin_amdgcn_mfma_f32_16x16x32_bf16(fal, bh1, acc1, 0, 0, 0); acc1 = __builtin_amdgcn_mfma_f32_16x16x32_bf16(fah, bl1, acc1, 0, 0, 0);
                  }
          *(pg8::u32x4*)(xo + 32 * (s2 + (g & 1)) + 8 * (g & 2) - 8 * g) = pg8::widen16(q8[0], q8[1]);
        }
        ssq += __shfl_xor(ssq, 16); ssq += __shfl_xor(ssq, 32);
        const float rstd = 1.0f / sqrtf(ssq * (1.f / D) + RMS_EPS);
#pragma unroll
        for (int j = 0; j < 4; ++j) { lg[(4 * g + j) * 33 + r16] = acc0[j]; lg[(4 * g + j) * 33 + 16 + r16] = acc1[j]; }
        if (lane < 16) lg[16 * 33 + lane] = rstd;
        LDS_WAIT(); asm volatile("" ::: "memory");
        int se[4] = {0, 0, 0, 0}, sp[4] = {0, 0, 0, 0}; float sg[4] = {0.f, 0.f, 0.f, 0.f}; float myr = 0.f;
        if (lane < 16) {
            myr = lg[16 * 33 + lane];
            float lv[32];
#pragma unroll
            for (int e = 0; e < 32; ++e) lv[e] = lg[lane * 33 + e] * myr + rb[e];
            unsigned used = 0u; float sv[4];
#pragma unroll
            for (int k = 0; k < 4; ++k) { float bv = -3.0e38f; int bi = 0;
#pragma unroll
                for (int e = 0; e < 32; ++e) { const bool ok = !((used >> e) & 1u) && lv[e] > bv; bv = ok ? lv[e] : bv; bi = ok ? e : bi; }
                used |= 1u << bi; se[k] = bi; sv[k] = bv; }
            const float e1 = __expf(sv[1] - sv[0]), e2 = __expf(sv[2] - sv[0]), e3 = __expf(sv[3] - sv[0]); const float inv = 1.0f / (1.0f + e1 + e2 + e3);
            sg[0] = inv; sg[1] = e1 * inv; sg[2] = e2 * inv; sg[3] = e3 * inv;
#pragma unroll
            for (int k = 0; k < 4; ++k) sp[k] = __hip_atomic_fetch_add(lcnt + se[k], 1, __ATOMIC_RELAXED, __HIP_MEMORY_SCOPE_WORKGROUP);
        }
        __syncthreads();
        if (F.tid < 32) lbase[F.tid] = (int)__hip_atomic_fetch_add((unsigned*)(F.ctl + CW_CNT + 64 * F.tid), (unsigned)lcnt[F.tid], RLX_AGENT);
        __syncthreads();
        if (lane < 16) { const int t = t0 + lane;
#pragma unroll
            for (int k = 0; k < 4; ++k) { const size_t p = (size_t)se[k] * ECAP + lbase[se[k]] + sp[k]; TOK[p] = t; GATE[p] = sg[k]; RS[p] = myr; SLOT[t * 4 + k] = (se[k] << 16) | (lbase[se[k]] + sp[k]); } }
        __syncthreads();
    }
}

__device__ __forceinline__ int moe_build_table(Frame& F, int nN, bool want_rows) {
    LAS int* tab = (LAS int*)(F.lds + TAB_OFF); LAS int* cl = (LAS int*)(F.lds + CNT_OFF); LAS int* rowsl = (LAS int*)(F.lds + ROWS_OFF);
    if (F.tid < 32) cl[F.tid] = (int)__hip_atomic_load((unsigned*)(F.ctl + CW_CNT + 64 * F.tid), RLX_AGENT);
    __syncthreads();
    int T = 0;
    for (int e = 0; e < NE; ++e) T += ((cl[e] + 255) >> 8) * nN;
    if (F.tid == 0) cl[33] = T;
    const int G = F.G, c = moe_pos(G);
    int n = (T > c) ? (T - c + G - 1) / G : 0; if (n > MAXU) n = MAXU;
    if (F.tid < n) {
        const int L = F.tid * G + c;
        int wgid = L; { const int q = T / 8, r = T % 8, xcd = wgid % 8, off = wgid / 8; wgid = (xcd < r ? xcd * (q + 1) : r * (q + 1) + (xcd - r) * q) + off; }
        int e = 0, pre = 0, rowblk = 0;
        for (; e < NE; ++e) { const int nM = (cl[e] + 255) >> 8, U = nM * nN; if (wgid < pre + U) break; pre += U; rowblk += nM; }
        if (e >= NE) e = NE - 1;
        const int nM = (cl[e] + 255) >> 8, w = wgid - pre, nig = 8 * nN, gid = w / nig, fm = gid * 8, gsz = (nM - fm) < 8 ? (nM - fm) : 8;
        const int pm = fm + ((w % nig) % gsz), pn = (w % nig) / gsz; int nv = cl[e] - pm * 256; nv = nv > 256 ? 256 : nv;
        tab[F.tid * 8 + 0] = e; tab[F.tid * 8 + 1] = pm; tab[F.tid * 8 + 2] = pn; tab[F.tid * 8 + 3] = nv; tab[F.tid * 8 + 4] = rowblk * 256;
    }
    __syncthreads();
    if (want_rows) { const int* TOK = (const int*)(F.ws + WS_TOK);
        int rv[MAXU / 2];
#pragma unroll
        for (int q = 0; q < MAXU / 2; ++q) { const int idx = F.tid + q * (NWAVES * 64), j = idx >> 8, r = idx & 255; rv[q] = 0;
            if (idx < n * 256) { const int e = tab[j * 8], pm = tab[j * 8 + 1], nv = tab[j * 8 + 3]; rv[q] = TOK[(size_t)e * ECAP + pm * 256 + (r < nv ? r : 0)]; } }
#pragma unroll
        for (int q = 0; q < MAXU / 2; ++q) { const int idx = F.tid + q * (NWAVES * 64); if (idx < n * 256) rowsl[idx] = rv[q]; }
        __syncthreads(); }
    return n;
}

__device__ __forceinline__ void final_phase(Frame& F, const Args& a) {
    const int lane_ = (int)__builtin_amdgcn_mbcnt_hi(~0u, __builtin_amdgcn_mbcnt_lo(~0u, 0u));
    float* OUT = a.out; const bf16* H = (const bf16*)(F.ws + WS_HB); const unsigned char* OB = F.ws + WS_OBUF; const float* fw = a.in[14]; const int* POS = (const int*)(F.ws + WS_SLOT);
    const int gw = F.vcu * NWAVES + F.wave, NGW = F.G * NWAVES;
    LAS int* rbase = (LAS int*)(F.lds + CNT_OFF);
    if (F.tid == 0) { int acc = 0; for (int e = 0; e < NE; ++e) { rbase[e] = acc; acc += (((int)__hip_atomic_load((unsigned*)(F.ctl + CW_CNT + 64 * e), RLX_AGENT) + 255) >> 8) * 256; } }
    __syncthreads();
    f32x4 wv[4];
#pragma unroll
    for (int j = 0; j < 4; ++j) wv[j] = *((const f32x4*)fw + lane_ + 64 * j);
    for (int m = gw; m < M; m += NGW) {
        GAS f32x4* hr = (GAS f32x4*)(OUT + (size_t)m * D) + lane_;
        const GAS v2u* hbr = (const GAS v2u*)(H + (size_t)m * D) + lane_;
        f32x4 v[4]; float s = 0.f;
#pragma unroll
        for (int j = 0; j < 4; ++j) { const v2u hw = __builtin_nontemporal_load(hbr + 64 * j); v[j] = (f32x4){bflo(hw.x), bfhi(hw.x), bflo(hw.y), bfhi(hw.y)}; }
        const v4i_t ps = *(const v4i_t*)(POS + (size_t)m * 4);
        int orow[4];
#pragma unroll
        for (int k = 0; k < 4; ++k) orow[k] = rbase[ps[k] >> 16] + (ps[k] & 0xffff);
        f32x4 y[4];
#pragma unroll
        for (int j = 0; j < 4; ++j) y[j] = (f32x4){0.f, 0.f, 0.f, 0.f};
#pragma unroll
        for (int k = 0; k < 4; ++k) { const GAS unsigned* op = (const GAS unsigned*)(OB + (size_t)orow[k] * D) + lane_;
#pragma unroll
            for (int j = 0; j < 4; ++j) { const int w = (int)__builtin_nontemporal_load(op + 64 * j);
                const f32x2 lo = __builtin_amdgcn_cvt_pk_f32_fp8(w, false), hi = __builtin_amdgcn_cvt_pk_f32_fp8(w, true);
                y[j].x += lo.x; y[j].y += lo.y; y[j].z += hi.x; y[j].w += hi.y; } }
#pragma unroll
        for (int j = 0; j < 4; ++j) v[j] += y[j] * (1.0f / O8S);
#pragma unroll
        for (int j = 0; j < 4; ++j) s += (v[j].x * v[j].x + v[j].y * v[j].y) + (v[j].z * v[j].z + v[j].w * v[j].w);
        const float rstd = 1.0f / sqrtf(wave_sum(s) * (1.f / D) + RMS_EPS);
#pragma unroll
        for (int j = 0; j < 4; ++j) hr[64 * j] = v[j] * rstd * wv[j];
    }
}

__global__ void __launch_bounds__(NWAVES * 64, 2) fwd_kernel(Args args) {
    extern __shared__ __attribute__((aligned(16))) unsigned char lds[];
    Frame F;
    F.lds = (LAS unsigned char*)lds;
    F.MISC = (volatile LAS unsigned*)(F.lds + MISC_OFF);
    F.tid = threadIdx.x; F.lane = F.tid & 63; F.wave = __builtin_amdgcn_readfirstlane(F.tid >> 6);
    F.G = gridDim.x; { const int bx = blockIdx.x; F.vcu = (F.G % 8 == 0) ? (bx % 8) * (F.G / 8) + bx / 8 : bx; }
    F.ws = args.ws; F.ctl = (gu32*)(args.ws + WS_CTL);
    if (F.tid < 32) F.MISC[F.tid] = 0u;
    __syncthreads();
    XcdBarrier bar = xcd_barrier_post((unsigned*)(F.ctl + CW_BAR), F.MISC + 8);
    const int lo = args.ph_lo, hi = args.ph_hi;
#define IN(k) (lo <= (k) && (k) < hi)
#define BOTH(k) (IN(k) && IN((k) + 1))
#define GRID_BAR() xcd_barrier(bar)

#ifndef DUP_PHASE
#define DUP_PHASE (-1)
#endif
#define PHASE_BEGIN(k) if (IN(k)) { for (int rep_ = 0; rep_ < ((DUP_PHASE == (k)) ? 2 : 1); ++rep_) { if (rep_) GRID_BAR();
#define PHASE_END(k) } if (BOTH(k)) GRID_BAR(); }
    PHASE_BEGIN(0) p0_prologue(F, args); PHASE_END(0)
    PHASE_BEGIN(1)
        pg8::DenseOrder S; S.init(F.ws + WS_XN, F.ws + WS_WIN, M, NPROJ, D, F.G, (int)blockIdx.x);
        pg8::EpiInProj E{(bf16*)(F.ws + WS_PROJ), (const float*)(F.ws + WS_LB)};
        moe_dn_filler(F, args, 0, true); __syncthreads();
        pg8::gemm_phase<pg8::EpiInProj, pg8::DenseOrder, false, true>(F.lds, D, S, E);
        moe_dn_filler(F, args, 0, false);
    PHASE_END(1)
    PHASE_BEGIN(2) hgrn_units2<0>(F, args, (int)blockIdx.x, F.G); attn_mfma(F, args, F.vcu, F.G); PHASE_END(2)
    PHASE_BEGIN(3) hgrn_scan(F); PHASE_END(3)
    PHASE_BEGIN(4) hgrn_units2<1>(F, args, (int)blockIdx.x, F.G); PHASE_END(4)
    PHASE_BEGIN(5)
        pg8::DenseOrder S; S.init(F.ws + WS_MIX, F.ws + WS_WOUT, M, D, D, F.G, (int)blockIdx.x);
        pg8::EpiOutProj E{args.in[0], (bf16*)(F.ws + WS_HB)};
        moe_dn_filler(F, args, 1, true); __syncthreads();
        pg8::gemm_phase<pg8::EpiOutProj, pg8::DenseOrder, false, true>(F.lds, D, S, E);
        moe_dn_filler(F, args, 1, false);
    PHASE_END(5)
    PHASE_BEGIN(6) moe_weights_to_fp8(F, args); __syncthreads(); router_phase(F, args); PHASE_END(6)
    PHASE_BEGIN(7)
        const int n = moe_build_table(F, 8, true);
        pg8::MoeOrder S{(const LAS int*)(F.lds + TAB_OFF), (const LAS int*)(F.lds + ROWS_OFF), n, (const char*)(F.ws + WS_XN), (const char*)(F.ws + WS_WGU), (size_t)2048 * 1024, D / 2, true};
        pg8::EpiSwiglu E{F.ws + WS_ACT, args.in[11], (const float*)(F.ws + WS_RS)};
        moe_stagger(F);
        pg8::gemm_phase<pg8::EpiSwiglu, pg8::MoeOrder, true, true, true>(F.lds, D / 2, S, E, F.lds + CB_OFF);
    PHASE_END(7)
    PHASE_BEGIN(8)
        const int n = moe_build_table(F, 4, false);
        pg8::MoeOrder S{(const LAS int*)(F.lds + TAB_OFF), (const LAS int*)(F.lds + ROWS_OFF), n, (const char*)(F.ws + WS_ACT), (const char*)(F.ws + WS_WDN), (size_t)1024 * 1024, D / 2, false};
        pg8::EpiDown E{F.ws + WS_OBUF, args.in[13], (const float*)(F.ws + WS_GATE)};
        moe_stagger(F);
        pg8::gemm_phase<pg8::EpiDown, pg8::MoeOrder, false, true, true>(F.lds, D / 2, S, E, F.lds + CB_OFF);
    PHASE_END(8)
    PHASE_BEGIN(9) final_phase(F, args); PHASE_END(9)
#undef IN
#undef BOTH
#undef GRID_BAR
}


#ifndef MK_N_LAUNCHES
#define MK_N_LAUNCHES 1
#endif
static void fill_buckets(Args& a) {
    const int dil[3] = {1, 4, 16};
    for (int p = 0; p < 3; ++p) for (int j = 0; j < 136; ++j) {
        int bkt = 0;
        if (j <= 128) { const int n = j * dil[p];
            if (n < 16) bkt = n;
            else { int large = 16 + (int)(std::log((double)n / 16.0) / std::log(2048.0 / 16.0) * 16.0); bkt = large < 31 ? large : 31; } }
        a.bkt[p][j] = (unsigned char)bkt; }
}
extern "C" void kernel_launch(void* const* d_in, const int* in_sizes, int n_in, void* d_out, int out_size, void* d_ws, size_t ws_size, hipStream_t stream) {
    static int grid = 0;
    if (grid == 0) {
        if (n_in != 15 || in_sizes[0] != M * D || out_size != M * D || ws_size < WS_END) { fprintf(stderr, "kernel_launch: unexpected shapes / workspace (n_in %d, ws %zu < %zu); nothing launched\n", n_in, ws_size, (size_t)WS_END); grid = -1; return; }
        int dev = 0, cus = 0;
        if (hipGetDevice(&dev) != hipSuccess || hipDeviceGetAttribute(&cus, hipDeviceAttributeMultiprocessorCount, dev) != hipSuccess) { grid = -1; return; }
        if (hipFuncSetAttribute((const void*)fwd_kernel, hipFuncAttributeMaxDynamicSharedMemorySize, LDS_BYTES) != hipSuccess) { fprintf(stderr, "kernel_launch: hipFuncSetAttribute failed\n"); grid = -1; return; }
        int per_cu = 0;
        if (hipOccupancyMaxActiveBlocksPerMultiprocessor(&per_cu, (const void*)fwd_kernel, NWAVES * 64, LDS_BYTES) != hipSuccess || per_cu < 1) fprintf(stderr, "kernel_launch: occupancy query says %d\n", per_cu);
        (void)hipGetLastError();
        grid = cus;
    }
    if (grid < 0) return;
    if (hipMemsetAsync((char*)d_ws + WS_CTL, 0, CTL_ZERO_BYTES, stream) != hipSuccess) return;
    Args a{};
    for (int i = 0; i < 15; ++i) a.in[i] = (const float*)d_in[i];
    a.out = (float*)d_out; a.ws = (unsigned char*)d_ws;
    fill_buckets(a);
    constexpr int NPH = 10;
#if MK_N_LAUNCHES == 1
    a.ph_lo = 0; a.ph_hi = NPH;
    hipLaunchKernelGGL(fwd_kernel, dim3(grid), dim3(NWAVES * 64), LDS_BYTES, stream, a);
#else
    for (int p = 0; p < NPH; ++p) { a.ph_lo = p; a.ph_hi = p + 1; hipLaunchKernelGGL(fwd_kernel, dim3(grid), dim3(NWAVES * 64), LDS_BYTES, stream, a); }
#endif
}
```

```cpp
#include <hip/hip_runtime.h>
#include <cstdio>
#include <cstdint>
#include <cmath>

#define GAS __attribute__((address_space(1)))
#define LAS __attribute__((address_space(3)))
typedef unsigned short bf16;
typedef unsigned v4u __attribute__((ext_vector_type(4)));
typedef unsigned v2u __attribute__((ext_vector_type(2)));
typedef float f32x4 __attribute__((ext_vector_type(4)));
typedef float f32x2 __attribute__((ext_vector_type(2)));
typedef short bf16x8 __attribute__((ext_vector_type(8)));
typedef GAS unsigned gu32;
#define RLX_AGENT __ATOMIC_RELAXED, __HIP_MEMORY_SCOPE_AGENT
#define LDS_WAIT() asm volatile("s_waitcnt lgkmcnt(0)" ::: "memory")
#define VM_WAIT() asm volatile("s_waitcnt vmcnt(0)" ::: "memory")

constexpr int D = 1024, BATCH = 8, SEQ = 4096, M = BATCH * SEQ;
constexpr int AH = 8, HD = 64;
constexpr int HH = 4, HK = 128;
constexpr int NPROJ = 3584;
constexpr int NE = 32, TOPK = 4;
constexpr int ECAP = 32768;
constexpr float RMS_EPS = 1e-5f;
constexpr float LOG2E = 1.4426950408889634f, LN2 = 0.6931471805599453f;
constexpr float QSCALE = 0.125f * LOG2E;

constexpr size_t MiB = 1u << 20;
constexpr size_t WS_CTL = 0, CTL_ZERO_BYTES = 48 * 1024;
constexpr size_t WS_LB = 1 * MiB;
constexpr size_t WS_WR = 1 * MiB + 65536;
constexpr size_t WS_WIN = 2 * MiB;
constexpr size_t WS_WOUT = 9 * MiB;
constexpr size_t WS_TOK = 11 * MiB, WS_SLOT = 15 * MiB, WS_GATE = 19 * MiB, WS_RS = 23 * MiB;
constexpr size_t WS_LSE = 27 * MiB;
constexpr size_t WS_WDN = 32 * MiB;
constexpr size_t WS_WGU = 96 * MiB;
constexpr size_t WS_XN = 224 * MiB;
constexpr size_t WS_MIX = 288 * MiB;
constexpr size_t WS_HB = 160 * MiB;
constexpr size_t WS_OBUF = 488 * MiB;
constexpr size_t WS_PROJ = 352 * MiB;
constexpr size_t WS_ATTP = 576 * MiB;
constexpr size_t WS_ACT = 352 * MiB;
constexpr size_t WS_HO = 672 * MiB;
constexpr size_t WS_END = 736 * MiB;
constexpr size_t PROJ_STRIDE = (size_t)M * 512;
constexpr int CW_TMO = 0, CW_CODE = 1, CW_BAR = 4096, CW_CNT = 8192;
static_assert((CW_BAR + 3456) <= CW_CNT && (size_t)(CW_CNT + 64 * 32) * 4 <= CTL_ZERO_BYTES, "control words inside the per-call memset");

constexpr int RING_BYTES = 131072;
constexpr int ROWS_OFF = RING_BYTES;
constexpr int MAXU = 20;
constexpr int TAB_OFF = ROWS_OFF + MAXU * 1024;
constexpr int CNT_OFF = TAB_OFF + MAXU * 32;
constexpr int MISC_OFF = CNT_OFF + 256;
constexpr int CB_OFF = MISC_OFF + 128;
constexpr int LDS_BYTES = 159744;
static_assert(CB_OFF % 16 == 0 && CB_OFF + 4096 <= LDS_BYTES, "LDS map");
constexpr int NWAVES = 8;

__device__ __forceinline__ unsigned f2bf(float f) { unsigned u = __builtin_bit_cast(unsigned, f); return (u + 0x7fffu + ((u >> 16) & 1u)) >> 16; }
__device__ __forceinline__ unsigned pk2(float lo, float hi) { unsigned r; asm volatile("v_cvt_pk_bf16_f32 %0, %1, %2" : "=v"(r) : "v"(lo), "v"(hi)); return r; }
__device__ __forceinline__ float bf2f(unsigned b) { return __builtin_bit_cast(float, b << 16); }
__device__ __forceinline__ float bflo(unsigned w) { return __builtin_bit_cast(float, w << 16); }
__device__ __forceinline__ float bfhi(unsigned w) { return __builtin_bit_cast(float, w & 0xffff0000u); }
typedef int v8i_t __attribute__((ext_vector_type(8)));
typedef int v4i_t __attribute__((ext_vector_type(4)));
constexpr float X8S = 16.0f, W8S = 256.0f, A8S = 8.0f, O8S = 32.0f;
__device__ __forceinline__ float clamp448(float x) { return __builtin_amdgcn_fmed3f(x, -448.0f, 448.0f); }
__device__ __forceinline__ unsigned pk4_fp8(float a, float b, float c, float d) { int w = 0; w = __builtin_amdgcn_cvt_pk_fp8_f32(clamp448(a), clamp448(b), w, false); w = __builtin_amdgcn_cvt_pk_fp8_f32(clamp448(c), clamp448(d), w, true); return (unsigned)w; }
__device__ __forceinline__ float fexp2(float x) { return __builtin_amdgcn_exp2f(x); }
__device__ __forceinline__ float frcp(float x) { return __builtin_amdgcn_rcpf(x); }
__device__ __forceinline__ float sigmoidf_(float x) { return frcp(1.0f + fexp2(-x * LOG2E)); }
__device__ __forceinline__ float siluf_(float x) { return x * sigmoidf_(x); }

namespace pg8 {
typedef unsigned u32x4 __attribute__((ext_vector_type(4)));
constexpr int BM = 256, BK = 64, HALF = 128, HTB = HALF * BK * 2, STAGE_BYTES = 8 * HTB, NXCD = 8, WGM = 8;
__host__ __device__ __forceinline__ int lds_byte(int r, int c) { const int st = (r >> 4) * 2 + (c >> 5), rr = r & 15, cc = c & 31, ob = rr * 64 + cc * 2; return st * 1024 + (ob ^ (((ob >> 9) & 1) << 5)); }
__host__ __device__ __forceinline__ void stage_rc(int b, int& R, int& C) { const int st = b / 1024, sb = b % 1024, swz = sb ^ (((sb >> 9) & 1) << 5); R = (st >> 1) * 16 + swz / 64; C = (st & 1) * 32 + (swz % 64) / 2; }
__host__ __device__ __forceinline__ int perm32(int rho) { const int n = rho >> 4, i = rho & 15; return 8 * (i >> 2) + 4 * n + (i & 3); }

struct Unit { const char* A; const char* B; const LAS int* rows; int pm, pn, e, nvalid, rowbase; };
__device__ __forceinline__ unsigned cvt_pk_bf16(float lo, float hi) { unsigned r; asm volatile("v_cvt_pk_bf16_f32 %0, %1, %2" : "=v"(r) : "v"(lo), "v"(hi)); return r; }

struct DenseOrder {
    const char* A; const char* B; int K, nM, nN, nwg, G, c;
    __device__ __forceinline__ void init(const void* A_, const void* B_, int M_, int N_, int K_, int G_, int c_) { A = (const char*)A_; B = (const char*)B_; K = K_; nM = M_ / BM; nN = N_ / BM; nwg = nM * nN; G = G_; c = c_; }
    __device__ __forceinline__ bool next(int i, Unit& u) const {
        const long L = (long)i * G + c; if (L >= nwg) return false;
        int wgid = (int)L; { const int q = nwg / NXCD, r = nwg % NXCD, xcd = wgid % NXCD, off = wgid / NXCD; wgid = (xcd < r ? xcd * (q + 1) : r * (q + 1) + (xcd - r) * q) + off; }
        const int nig = WGM * nN, gid = wgid / nig, fm = gid * WGM, gsz = (nM - fm) < WGM ? (nM - fm) : WGM;
        u.pm = fm + ((wgid % nig) % gsz); u.pn = (wgid % nig) / gsz; u.e = 0; u.nvalid = 256; u.rowbase = 0; u.rows = nullptr;
        if (nN == 14) { const int q_ = u.pn; u.pn = (q_ < 8) ? q_ : (q_ < 10 ? q_ + 4 : q_ - 2); }
        u.A = A + (size_t)u.pm * ((size_t)BM * K * 2); u.B = B + (size_t)u.pn * ((size_t)BM * K * 2); return true;
    }
};
struct MoeOrder {
    const LAS int* tab; const LAS int* rows; int n; const char* A; const char* B; size_t bstride; int K; bool gather;
    __device__ __forceinline__ bool next(int i, Unit& u) const {
        if (i >= n) return false;
        const LAS int* t = tab + i * 8;
        u.e = __builtin_amdgcn_readfirstlane(t[0]); u.pm = __builtin_amdgcn_readfirstlane(t[1]); u.pn = __builtin_amdgcn_readfirstlane(t[2]);
        u.nvalid = __builtin_amdgcn_readfirstlane(t[3]); u.rowbase = __builtin_amdgcn_readfirstlane(t[4]);
        u.B = B + (size_t)u.e * bstride + (size_t)u.pn * ((size_t)BM * K * 2);
        if (gather) { u.A = A; u.rows = rows + i * 256; }
        else { u.A = A + (size_t)(u.rowbase + u.pm * 256) * ((size_t)K * 2); u.rows = nullptr; }
        return true;
    }
};

template <class Epi, class Sched, bool GATHER, bool ALIGN_EPI, bool FP8 = false>
__device__ __forceinline__ void gemm_phase(LAS unsigned char* lds, const int K, const Sched& S, const Epi& E, LAS unsigned char* cbuf = nullptr) {
    const int tid = threadIdx.x, wid = __builtin_amdgcn_readfirstlane(tid >> 6), lane = tid & 63, wr = wid >> 2, wc = wid & 3, fr = lane & 15, fq = lane >> 4;
    const int nt = K / BK;
    unsigned voffA[2], voffB[2], cA2[2]; int rA[2];
#pragma unroll
    for (int i = 0; i < 2; ++i) { int R, C; stage_rc(tid * 16 + i * 8192, R, C); const int Rb = Epi::PERM ? ((R & ~31) + perm32(R & 31)) : R;
        voffA[i] = (unsigned)(R * K + C) * 2u; voffB[i] = (unsigned)(Rb * K + C) * 2u; rA[i] = R; cA2[i] = (unsigned)C * 2u; }
    const size_t kstep = (size_t)(BK * 2);
    const size_t hstep = (size_t)HALF * K * 2;
    const unsigned ldsw = (unsigned)wid * 1024u;
    const int aoff = lds_byte(wr * 64 + fr, fq * 8), boff = lds_byte(wc * 32 + fr, fq * 8);
#define PG8_SA(b, h) (((b) * 2 + (h)) * HTB)
#define PG8_SB(b, h) ((4 + (b) * 2 + (h)) * HTB)
#define PG8_STAGE(bufoff, gbase, voff) do { _Pragma("unroll") for (int _i = 0; _i < 2; ++_i) \
        __builtin_amdgcn_global_load_lds((const unsigned*)((const char*)(gbase) + (voff)[_i]), (LAS unsigned*)(lds + (bufoff) + ldsw + _i * 8192), 16, 0, 0); } while (0)
#define PG8_STAGE_A(b, h, aptr, G) do { if constexpr (GATHER) { PG8_STAGE(PG8_SA(b, h), aptr, G[h]); } else { PG8_STAGE(PG8_SA(b, h), (aptr) + (h) * hstep, voffA); } } while (0)
#define PG8_LD8(addr) __builtin_shufflevector(*(const LAS v4i_t*)(addr), *(const LAS v4i_t*)((addr) + 1024), 0, 1, 2, 3, 4, 5, 6, 7)
#define PG8_LDA(dst, b, h) do { if constexpr (FP8) { _Pragma("unroll") for (int m = 0; m < 4; ++m) dst##8[m] = PG8_LD8(lds + PG8_SA(b, h) + aoff + m * 2048); } \
        else { _Pragma("unroll") for (int m = 0; m < 4; ++m) _Pragma("unroll") for (int k = 0; k < 2; ++k) dst[m][k] = *(const LAS bf16x8*)(lds + PG8_SA(b, h) + aoff + m * 2048 + k * 1024); } } while (0)
#define PG8_LDB(dst, b, h) do { if constexpr (FP8) { _Pragma("unroll") for (int n = 0; n < 2; ++n) dst##8[n] = PG8_LD8(lds + PG8_SB(b, h) + boff + n * 2048); } \
        else { _Pragma("unroll") for (int n = 0; n < 2; ++n) _Pragma("unroll") for (int k = 0; k < 2; ++k) dst[n][k] = *(const LAS bf16x8*)(lds + PG8_SB(b, h) + boff + n * 2048 + k * 1024); } } while (0)
#define PG8_MMA(ai, bj, At, Bt) do { __builtin_amdgcn_s_setprio(1); \
        if constexpr (FP8) { _Pragma("unroll") for (int m = 0; m < 4; ++m) _Pragma("unroll") for (int n = 0; n < 2; ++n) \
            asm volatile("v_mfma_f32_16x16x128_f8f6f4 %0, %1, %2, %0" : "+v"(acc[ai][bj][m][n]) : "v"(Bt##8[n]), "v"(At##8[m])); } \
        else { _Pragma("unroll") for (int k = 0; k < 2; ++k) _Pragma("unroll") for (int m = 0; m < 4; ++m) _Pragma("unroll") for (int n = 0; n < 2; ++n) \
            asm volatile("v_mfma_f32_16x16x32_bf16 %0, %1, %2, %0" : "+v"(acc[ai][bj][m][n]) : "v"(Bt[n][k]), "v"(At[m][k])); } \
        __builtin_amdgcn_s_setprio(0); } while (0)
#define PG8_MMA0(ai, bj, At, Bt) do { __builtin_amdgcn_s_setprio(1); \
        if constexpr (FP8) { _Pragma("unroll") for (int m = 0; m < 4; ++m) _Pragma("unroll") for (int n = 0; n < 2; ++n) \
            asm volatile("v_mfma_f32_16x16x128_f8f6f4 %0, %1, %2, 0" : "=v"(acc[ai][bj][m][n]) : "v"(Bt##8[n]), "v"(At##8[m])); } \
        else { _Pragma("unroll") for (int m = 0; m < 4; ++m) _Pragma("unroll") for (int n = 0; n < 2; ++n) \
            asm volatile("v_mfma_f32_16x16x32_bf16 %0, %1, %2, 0" : "=v"(acc[ai][bj][m][n]) : "v"(Bt[n][0]), "v"(At[m][0])); \
            _Pragma("unroll") for (int m = 0; m < 4; ++m) _Pragma("unroll") for (int n = 0; n < 2; ++n) \
            asm volatile("v_mfma_f32_16x16x32_bf16 %0, %1, %2, %0" : "+v"(acc[ai][bj][m][n]) : "v"(Bt[n][1]), "v"(At[m][1])); } \
        __builtin_amdgcn_s_setprio(0); } while (0)
#define PG8_WAIT_V(n) asm volatile("s_waitcnt vmcnt(" #n ")" ::: "memory")
#define PG8_WAIT_L(n) asm volatile("s_waitcnt lgkmcnt(" #n ")" ::: "memory")
#define PG8_BAR __builtin_amdgcn_s_barrier()
#define PG8_SCHED __builtin_amdgcn_sched_barrier(0)
#define PG8_GLOAD(G, u) do { _Pragma("unroll") for (int _h = 0; _h < 2; ++_h) _Pragma("unroll") for (int _i = 0; _i < 2; ++_i) { int _r = rA[_i] + HALF * _h; _r = _r < (u).nvalid ? _r : 0; \
        G[_h][_i] = (unsigned)(u).rows[_r] * (unsigned)(K * 2) + cA2[_i]; } } while (0)
#define PG8_ITER(FIRSTV) do { constexpr bool FIRST_ = (FIRSTV); \
            const bool last = (t == nt - 2); \
            const char* a1 = cA + (size_t)(t + 1) * kstep; \
            const char* a2 = last ? nA : cA + (size_t)(t + 2) * kstep; const char* b2 = last ? nB : cB + (size_t)(t + 2) * kstep; \
            const char* a3 = a2 + kstep; const char* b3 = b2 + kstep; \
            const bool relax = (t == 0) && (ui > 0); \
            PG8_LDB(B0, 0, 0); PG8_LDB(B1, 0, 1); PG8_SCHED; PG8_LDA(At, 0, 0); PG8_STAGE_A(1, 1, a1, gc); \
            if constexpr (GATHER) { if (last && has_next) { PG8_GLOAD(gc, nxt); } } \
            if (relax) { asm volatile("s_waitcnt vmcnt(%0)" :: "n"(8 + Epi::NE) : "memory"); } else { PG8_WAIT_V(8); } \
            PG8_WAIT_L(0); PG8_BAR; if constexpr (FIRST_) { PG8_MMA0(0, 0, At, B0); PG8_MMA0(0, 1, At, B1); } else { PG8_MMA(0, 0, At, B0); PG8_MMA(0, 1, At, B1); } PG8_BAR; PG8_SCHED; \
            PG8_LDA(At, 0, 1); PG8_STAGE(PG8_SB(0, 0), b2, voffB); PG8_STAGE(PG8_SB(0, 1), b2 + hstep, voffB); PG8_STAGE_A(0, 0, a2, gc); \
            if (relax) { asm volatile("s_waitcnt vmcnt(%0)" :: "n"(8 + Epi::NE) : "memory"); } else { PG8_WAIT_V(8); } \
            PG8_WAIT_L(0); PG8_BAR; if constexpr (FIRST_) { PG8_MMA0(1, 0, At, B0); PG8_MMA0(1, 1, At, B1); } else { PG8_MMA(1, 0, At, B0); PG8_MMA(1, 1, At, B1); } PG8_BAR; PG8_SCHED; \
            PG8_LDB(B0, 1, 0); PG8_LDB(B1, 1, 1); PG8_SCHED; PG8_LDA(At, 1, 0); PG8_STAGE_A(0, 1, a2, gc); \
            PG8_WAIT_V(8); PG8_WAIT_L(0); PG8_BAR; PG8_MMA(0, 0, At, B0); PG8_MMA(0, 1, At, B1); PG8_BAR; PG8_SCHED; \
            PG8_LDA(At, 1, 1); PG8_STAGE(PG8_SB(1, 0), b3, voffB); PG8_STAGE(PG8_SB(1, 1), b3 + hstep, voffB); PG8_STAGE_A(1, 0, a3, gc); \
            PG8_WAIT_V(8); PG8_WAIT_L(0); PG8_BAR; PG8_MMA(1, 0, At, B0); PG8_MMA(1, 1, At, B1); PG8_BAR; PG8_SCHED; \
        } while (0)
    Unit cur, nxt; int ui = 0;
    if (!S.next(0, cur)) return;
    f32x4 acc[2][2][4][2];
    bf16x8 At[4][2], B0[2][2], B1[2][2]; v8i_t At8[4], B08[2], B18[2];
    unsigned gc[2][2] = {{0u, 0u}, {0u, 0u}};
    if constexpr (GATHER) { PG8_GLOAD(gc, cur); }
    const char* cA = cur.A; const char* cB = cur.B;
    PG8_STAGE(PG8_SB(0, 0), cB, voffB); PG8_STAGE(PG8_SB(0, 1), cB + hstep, voffB); PG8_STAGE_A(0, 0, cA, gc); PG8_STAGE_A(0, 1, cA, gc);
    if (wr == 1) PG8_BAR;
    PG8_WAIT_V(2); PG8_BAR;
    PG8_STAGE(PG8_SB(1, 0), cB + kstep, voffB); PG8_STAGE_A(1, 0, cA + kstep, gc); PG8_STAGE(PG8_SB(1, 1), cB + hstep + kstep, voffB);
    PG8_WAIT_V(6); PG8_BAR;
    for (;;) {
        if constexpr (Epi::HAS_PF) { if (wid == 0) E.prefetch(cur, cbuf + (ui & 1) * 2048, lane); }
        const bool has_next = S.next(ui + 1, nxt);
        const char* nA = has_next ? nxt.A : cA; const char* nB = has_next ? nxt.B : cB;
        { const int t = 0; PG8_ITER(true); }
#pragma unroll 1
        for (int t = 2; t < nt; t += 2) { PG8_ITER(false); }
        if constexpr (ALIGN_EPI) { if (wr == 0) PG8_BAR; }
        { PG8_SCHED; asm volatile("s_nop 15\n\ts_nop 15" ::: "memory"); PG8_SCHED; }
        E(acc, cur, wr, wc, fr, fq, cbuf + (ui & 1) * 2048);
        if (!has_next) break;
        cur = nxt; cA = nA; cB = nB; ++ui;
        if constexpr (ALIGN_EPI) { if (wr == 1) PG8_BAR; }
    }
    PG8_WAIT_V(0);
    if constexpr (!ALIGN_EPI) { if (wr == 0) PG8_BAR; }
    PG8_BAR;
#undef PG8_SA
#undef PG8_SB
#undef PG8_STAGE
#undef PG8_STAGE_A
#undef PG8_LDA
#undef PG8_LDB
#undef PG8_MMA
#undef PG8_MMA0
#undef PG8_ITER
#undef PG8_LD8
#undef PG8_WAIT_V
#undef PG8_WAIT_L
#undef PG8_BAR
#undef PG8_SCHED
#undef PG8_GLOAD
}

struct EpiInProj {
    static constexpr bool PERM = true, HAS_PF = false; static constexpr int NE = 12;
    bf16* proj; const float* lb;
    __device__ __forceinline__ void operator()(const f32x4 (&acc)[2][2][4][2], const Unit& u, int wr, int wc, int fr, int fq, const LAS unsigned char*) const {
        const int t = u.pn >> 1;
        bf16* base = proj + (size_t)t * PROJ_STRIDE;
        const int row0 = u.pm * BM + wr * 64 + fr, col0 = (u.pn & 1) * 256 + wc * 32 + 8 * fq;
        f32x4 lbv[2][2];
#pragma unroll
        for (int bj = 0; bj < 2; ++bj)
#pragma unroll
            for (int n = 0; n < 2; ++n) lbv[bj][n] = (t == 4) ? *(const f32x4*)(lb + col0 + bj * HALF + 4 * n) : (f32x4){0.f, 0.f, 0.f, 0.f};
#pragma unroll
        for (int ai = 0; ai < 2; ++ai)
#pragma unroll
            for (int m = 0; m < 4; ++m) { bf16* rowp = base + (size_t)(row0 + ai * HALF + m * 16) * 512 + col0;
#pragma unroll
                for (int bj = 0; bj < 2; ++bj) { f32x4 v[2] = {acc[ai][bj][m][0], acc[ai][bj][m][1]};
                    if (t == 0) { v[0] = v[0] * QSCALE; v[1] = v[1] * QSCALE; }
                    else if (t == 3) {
#pragma unroll
                        for (int n = 0; n < 2; ++n)
#pragma unroll
                            for (int j = 0; j < 4; ++j) v[n][j] = siluf_(v[n][j]) * 0.08838834764831845f; }
                    else if (t == 4) {
#pragma unroll
                        for (int n = 0; n < 2; ++n)
#pragma unroll
                            for (int j = 0; j < 4; ++j) { const float l = lbv[bj][n][j]; const float f = l + (1.0f - l) * sigmoidf_(v[n][j]); v[n][j] = __builtin_amdgcn_logf(f) * LN2; } }
                    else if (t == 6) {
#pragma unroll
                        for (int n = 0; n < 2; ++n)
#pragma unroll
                            for (int j = 0; j < 4; ++j) v[n][j] = siluf_(v[n][j]); }
                    u32x4 w; w.x = cvt_pk_bf16(v[0][0], v[0][1]); w.y = cvt_pk_bf16(v[0][2], v[0][3]); w.z = cvt_pk_bf16(v[1][0], v[1][1]); w.w = cvt_pk_bf16(v[1][2], v[1][3]);
                    *(u32x4*)(rowp + bj * HALF) = w; } }
    }
};
struct EpiOutProj {
    static constexpr bool PERM = true, HAS_PF = false; static constexpr int NE = 28;
    const float* x; bf16* hb;
    __device__ __forceinline__ void operator()(const f32x4 (&acc)[2][2][4][2], const Unit& u, int wr, int wc, int fr, int fq, const LAS unsigned char*) const {
        const int row0 = u.pm * BM + wr * 64 + fr, col0 = u.pn * BM + wc * 32 + 8 * fq;
#pragma unroll
        for (int ai = 0; ai < 2; ++ai)
#pragma unroll
            for (int m = 0; m < 4; ++m) { const size_t off = (size_t)(row0 + ai * HALF + m * 16) * D + col0;
#pragma unroll
                for (int bj = 0; bj < 2; ++bj) { const size_t p = off + bj * HALF;
                    const f32x4 v0 = __builtin_nontemporal_load((const f32x4*)(x + p)) + acc[ai][bj][m][0], v1 = __builtin_nontemporal_load((const f32x4*)(x + p + 4)) + acc[ai][bj][m][1];
                    u32x4 w; w.x = cvt_pk_bf16(v0[0], v0[1]); w.y = cvt_pk_bf16(v0[2], v0[3]); w.z = cvt_pk_bf16(v1[0], v1[1]); w.w = cvt_pk_bf16(v1[2], v1[3]);
                    *(u32x4*)(hb + p) = w; } }
    }
};
__device__ __forceinline__ u32x4 widen16(v2u a, v2u b) {
    const auto r0 = __builtin_amdgcn_permlane16_swap(a.x, b.x, false, false), r1 = __builtin_amdgcn_permlane16_swap(a.y, b.y, false, false);
    return (u32x4){r0[0], r1[0], r0[1], r1[1]};
}
struct EpiSwiglu {
    static constexpr bool PERM = true, HAS_PF = true; static constexpr int NE = 4;
    unsigned char* act; const float* bgu; const float* rs;
    __device__ __forceinline__ void prefetch(const Unit& u, LAS unsigned char* cb, int lane) const {
        const float* b0 = bgu + (size_t)u.e * 2048 + u.pn * 128 + (lane < 32 ? lane * 4 : 1024 + (lane - 32) * 4);
        __builtin_amdgcn_global_load_lds((const unsigned*)b0, (LAS unsigned*)cb, 16, 0, 0);
        __builtin_amdgcn_global_load_lds((const unsigned*)(rs + (size_t)u.e * ECAP + u.pm * 256 + lane * 4), (LAS unsigned*)(cb + 1024), 16, 0, 0);
    }
    __device__ __forceinline__ void operator()(const f32x4 (&acc)[2][2][4][2], const Unit& u, int wr, int wc, int fr, int fq, const LAS unsigned char* cb) const {
        const int cl = wc * 32 + 8 * fq, odd = fq & 1, colW = u.pn * 128 + wc * 32 + 8 * (fq & 2);
        f32x4 bgv[2], buv[2];
#pragma unroll
        for (int n = 0; n < 2; ++n) { bgv[n] = *(const LAS f32x4*)(cb + (cl + 4 * n) * 4); buv[n] = *(const LAS f32x4*)(cb + 512 + (cl + 4 * n) * 4); }
        float rs8[2][4];
#pragma unroll
        for (int ai = 0; ai < 2; ++ai)
#pragma unroll
            for (int m = 0; m < 4; ++m) rs8[ai][m] = *(const LAS float*)(cb + 1024 + (ai * HALF + wr * 64 + m * 16 + fr) * 4);
#pragma unroll
        for (int ai = 0; ai < 2; ++ai)
#pragma unroll
            for (int mp = 0; mp < 2; ++mp) { v2u wv[2];
#pragma unroll
                for (int h = 0; h < 2; ++h) { const int m = 2 * mp + h, rl = ai * HALF + wr * 64 + m * 16 + fr; const float rstd = (rl < u.nvalid) ? rs8[ai][m] * (1.0f / (X8S * W8S)) : 0.f;
                    unsigned w[2];
#pragma unroll
                    for (int n = 0; n < 2; ++n) { float o[4];
#pragma unroll
                        for (int j = 0; j < 4; ++j) { float g = acc[ai][0][m][n][j] * rstd + bgv[n][j], up = acc[ai][1][m][n][j] * rstd + buv[n][j];
                            g = fminf(g, 7.0f); up = __builtin_amdgcn_fmed3f(up, -7.0f, 7.0f); o[j] = (g * frcp(1.0f + fexp2(-1.702f * LOG2E * g))) * (up * A8S + A8S); }
                        int w_ = 0; w_ = __builtin_amdgcn_cvt_pk_fp8_f32(o[0], o[1], w_, false); w_ = __builtin_amdgcn_cvt_pk_fp8_f32(o[2], o[3], w_, true); w[n] = (unsigned)w_; }
                    wv[h] = (v2u){w[0], w[1]}; }
                const int rs = ai * HALF + wr * 64 + (2 * mp + odd) * 16 + fr;
                *(u32x4*)(act + (size_t)(u.rowbase + u.pm * 256 + rs) * 1024 + colW) = widen16(wv[0], wv[1]); }
    }
};
struct EpiDown {
    static constexpr bool PERM = true, HAS_PF = true; static constexpr int NE = 8;
    unsigned char* obuf; const float* bdn; const float* gate;
    __device__ __forceinline__ void prefetch(const Unit& u, LAS unsigned char* cb, int lane) const {
        __builtin_amdgcn_global_load_lds((const unsigned*)(bdn + (size_t)u.e * 1024 + u.pn * 256 + lane * 4), (LAS unsigned*)cb, 16, 0, 0);
        __builtin_amdgcn_global_load_lds((const unsigned*)(gate + (size_t)u.e * ECAP + u.pm * 256 + lane * 4), (LAS unsigned*)(cb + 1024), 16, 0, 0);
    }
    __device__ __forceinline__ void operator()(const f32x4 (&acc)[2][2][4][2], const Unit& u, int wr, int wc, int fr, int fq, const LAS unsigned char* cb) const {
        const int cl = wc * 32 + 8 * fq, odd = fq & 1, colW = u.pn * BM + wc * 32 + 8 * (fq & 2);
        f32x4 bv[2][2];
#pragma unroll
        for (int bj = 0; bj < 2; ++bj)
#pragma unroll
            for (int n = 0; n < 2; ++n) bv[bj][n] = *(const LAS f32x4*)(cb + (bj * HALF + cl + 4 * n) * 4);
        float gt8[2][4];
#pragma unroll
        for (int ai = 0; ai < 2; ++ai)
#pragma unroll
            for (int m = 0; m < 4; ++m) gt8[ai][m] = *(const LAS float*)(cb + 1024 + (ai * HALF + wr * 64 + m * 16 + fr) * 4);
#pragma unroll
        for (int ai = 0; ai < 2; ++ai)
#pragma unroll
            for (int mp = 0; mp < 2; ++mp) { v2u wv[2][2];
#pragma unroll
                for (int h = 0; h < 2; ++h) { const int m = 2 * mp + h; const float gt = gt8[ai][m] * O8S;
#pragma unroll
                    for (int bj = 0; bj < 2; ++bj) { const f32x4 v0 = (acc[ai][bj][m][0] * (1.0f / (A8S * W8S)) + bv[bj][0]) * gt, v1 = (acc[ai][bj][m][1] * (1.0f / (A8S * W8S)) + bv[bj][1]) * gt;
                        wv[h][bj] = (v2u){pk4_fp8(v0[0], v0[1], v0[2], v0[3]), pk4_fp8(v1[0], v1[1], v1[2], v1[3])}; } }
                unsigned char* rowp = obuf + (size_t)(u.rowbase + u.pm * 256 + ai * HALF + wr * 64 + (2 * mp + odd) * 16 + fr) * 1024 + colW;
#pragma unroll
                for (int bj = 0; bj < 2; ++bj) *(u32x4*)(rowp + bj * HALF) = widen16(wv[0][bj], wv[1][bj]); }
    }
};
}

#define XB_TMO      128
#define XB_XCNT(j)  (256  + 64 * (j))
#define XB_XSUB(j)  (1280 + 64 * (j))
#define XB_XGEN(j)  (2304 + 64 * (j))
#define XB_TOP      3328
#define XB_TOPGEN   3392
#define XCD_BAR_WORDS 3456
#define XB_SPIN_CAP (1u << 18)
__device__ __forceinline__ unsigned xb_ld(unsigned* p)              { return __hip_atomic_load(p, __ATOMIC_RELAXED, __HIP_MEMORY_SCOPE_AGENT); }
__device__ __forceinline__ unsigned xb_add(unsigned* p, unsigned v) { return __hip_atomic_fetch_add(p, v, __ATOMIC_RELAXED, __HIP_MEMORY_SCOPE_AGENT); }
__device__ __forceinline__ unsigned xb_xcc_id() { return (unsigned)__builtin_amdgcn_s_getreg((3 << 11) | 20) & 0xFu; }
#define XB_SPIN(cond, bar) do { unsigned _sp = 0; while (cond) { __builtin_amdgcn_s_sleep(1); \
    if ((++_sp & 255u) == 0u) { if (xb_ld(&(bar)[XB_TMO])) break; if (_sp > XB_SPIN_CAP) { atomicAdd(&(bar)[XB_TMO], 1u); break; } } } } while (0)
struct XcdBarrier { unsigned* bar; unsigned x; volatile LAS unsigned* st; };
__device__ __forceinline__ XcdBarrier xcd_barrier_post(unsigned* bar, volatile LAS unsigned* st) {
    XcdBarrier b; b.bar = bar; b.x = xb_xcc_id(); b.st = st;
    if (threadIdx.x == 0) (void)xb_add(&bar[XB_XCNT(b.x)], 1u);
    return b;
}
__device__ __forceinline__ void xcd_barrier_complete(unsigned* bar, unsigned x, unsigned& nloc, unsigned& nx) {
    const unsigned G = gridDim.x * gridDim.y * gridDim.z;
    unsigned sum, cnt, mine, sp = 0u;
    for (;;) {
        sum = 0u; cnt = 0u; mine = 0u;
#pragma unroll
        for (unsigned j = 0; j < 16; ++j) { const unsigned c = xb_ld(&bar[XB_XCNT(j)]); sum += c; cnt += (c > 0u) ? 1u : 0u; mine = (j == x) ? c : mine; }
        if (sum == G) break;
        __builtin_amdgcn_s_sleep(1);
        if ((++sp & 255u) == 0u) { if (xb_ld(&bar[XB_TMO])) break; if (sp > XB_SPIN_CAP) { atomicAdd(&bar[XB_TMO], 1u); break; } }
    }
    nloc = mine > 0u ? mine : 1u; nx = cnt > 0u ? cnt : 1u;
}
__device__ __forceinline__ void xcd_barrier(const XcdBarrier& b) {
    asm volatile("s_waitcnt vmcnt(0)" ::: "memory");
    __syncthreads();
    if (threadIdx.x == 0) {
        unsigned* bar = b.bar;
        __builtin_amdgcn_s_waitcnt(0);
        unsigned nloc = b.st[0], nx = b.st[1];
        if (nloc == 0u) { xcd_barrier_complete(bar, b.x, nloc, nx); b.st[0] = nloc; b.st[1] = nx; }
        const unsigned old = xb_add(&bar[XB_XSUB(b.x)], 1u);
        const unsigned gen = old / nloc;
        if (old + 1u == (gen + 1u) * nloc) {
            __builtin_amdgcn_fence(__ATOMIC_RELEASE, "agent");
            asm volatile("s_waitcnt vmcnt(0)" ::: "memory");
            const unsigned og = xb_add(&bar[XB_TOP], 1u);
            const unsigned tg = og / nx;
            if (og + 1u == (tg + 1u) * nx) xb_add(&bar[XB_TOPGEN], 1u);
            else XB_SPIN(xb_ld(&bar[XB_TOPGEN]) == tg, bar);
            __builtin_amdgcn_fence(__ATOMIC_ACQUIRE, "agent");
            xb_add(&bar[XB_XGEN(b.x)], 1u);
            asm volatile("s_waitcnt vmcnt(0)" ::: "memory");
        } else {
            XB_SPIN(xb_ld(&bar[XB_XGEN(b.x)]) == gen, bar);
            __builtin_amdgcn_fence(__ATOMIC_ACQUIRE, "agent");
            asm volatile("s_waitcnt vmcnt(0)" ::: "memory");
        }
    }
    __syncthreads();
}

struct Args { const float* in[15]; float* out; unsigned char* ws; int ph_lo, ph_hi; unsigned char bkt[3][136]; };
struct Frame {
    LAS unsigned char* lds; volatile LAS unsigned* MISC; gu32* ctl;
    int tid, lane, wave, vcu, G;
    unsigned char* ws;
};
__device__ __forceinline__ float wave_sum(float v) {
#pragma unroll
    for (int o = 1; o < 64; o <<= 1) v += __shfl_xor(v, o);
    return v;
}
__device__ __forceinline__ float wave_max(float v) {
#pragma unroll
    for (int o = 1; o < 64; o <<= 1) v = fmaxf(v, __shfl_xor(v, o));
    return v;
}

__device__ __forceinline__ void p0_transpose_item(const float* W, int K, int N, bf16* WT, int kb, int nb, int dst_row0, LAS float* scr, int lane) {
    const int k0 = 64 * kb, n0 = 32 * nb;
    float wv_[32];
#pragma unroll
    for (int i = 0; i < 32; ++i) wv_[i] = __builtin_nontemporal_load(W + (size_t)(k0 + 2 * i + (lane >> 5)) * N + n0 + (lane & 31));
#pragma unroll
    for (int i = 0; i < 32; ++i) scr[(2 * i + (lane >> 5)) * 33 + (lane & 31)] = wv_[i];
    LDS_WAIT(); asm volatile("" ::: "memory");
    const int c = lane & 7;
#pragma unroll
    for (int j = 0; j < 4; ++j) { const int n = (lane >> 3) + 8 * j; const LAS float* s = scr + (8 * c) * 33 + n;
        v4u o; o.x = pk2(s[0 * 33], s[1 * 33]); o.y = pk2(s[2 * 33], s[3 * 33]); o.z = pk2(s[4 * 33], s[5 * 33]); o.w = pk2(s[6 * 33], s[7 * 33]);
        *(GAS v4u*)(WT + (size_t)(dst_row0 + n) * K + k0 + 8 * c) = o; }
    LDS_WAIT(); asm volatile("" ::: "memory");
}
__device__ __forceinline__ void p0_transpose_item_fp8(const float* W, int K, int N, unsigned char* WT, int kb, int nb, int dst_row0, LAS float* scr, int lane) {
    const int k0 = 64 * kb, n0 = 32 * nb;
    float wv_[32];
#pragma unroll
    for (int i = 0; i < 32; ++i) wv_[i] = __builtin_nontemporal_load(W + (size_t)(k0 + 2 * i + (lane >> 5)) * N + n0 + (lane & 31));
#pragma unroll
    for (int i = 0; i < 32; ++i) scr[(2 * i + (lane >> 5)) * 33 + (lane & 31)] = wv_[i];
    LDS_WAIT(); asm volatile("" ::: "memory");
    const int c = lane & 7;
#pragma unroll
    for (int j = 0; j < 4; ++j) { const int n = (lane >> 3) + 8 * j; const LAS float* sp = scr + (8 * c) * 33 + n;
        v2u o; o.x = pk4_fp8(sp[0 * 33] * W8S, sp[1 * 33] * W8S, sp[2 * 33] * W8S, sp[3 * 33] * W8S); o.y = pk4_fp8(sp[4 * 33] * W8S, sp[5 * 33] * W8S, sp[6 * 33] * W8S, sp[7 * 33] * W8S);
        *(GAS v2u*)(WT + (size_t)(dst_row0 + n) * K + k0 + 8 * c) = o; }
    LDS_WAIT(); asm volatile("" ::: "memory");
}
__device__ __forceinline__ void p0_prologue(Frame& F, const Args& a) {
    LAS float* scr = (LAS float*)(F.lds + F.wave * 16384);
    const int gw = F.vcu * NWAVES + F.wave, NGW = F.G * NWAVES;
    const float* w_in = a.in[2]; const float* w_out = a.in[6];
    bf16* WIN = (bf16*)(F.ws + WS_WIN); bf16* WOUT = (bf16*)(F.ws + WS_WOUT);
    constexpr int I_IN = 16 * 112, I_OUT = 16 * 32;
    constexpr int NITEMS = I_IN + I_OUT;
    for (int it = gw; it < NITEMS; it += NGW) {
        int r = it;
        if (r < I_IN) { p0_transpose_item(w_in, D, NPROJ, WIN, r / 112, r % 112, 32 * (r % 112), scr, F.lane); continue; } r -= I_IN;
        p0_transpose_item(w_out, D, D, WOUT, r / 32, r % 32, 32 * (r % 32), scr, F.lane);
    }
    { const int gt = (F.vcu * NWAVES + F.wave) * 64 + F.lane, NT = F.G * NWAVES * 64;
        const float* rw = a.in[8]; const float* nf = a.in[7]; bf16* WR = (bf16*)(F.ws + WS_WR);
        for (int idx = gt; idx < D * NE; idx += NT) { const int k = idx >> 5, e = idx & 31; const float v = rw[idx] * nf[k]; const unsigned hi = f2bf(v); const unsigned lo = f2bf(v - bf2f(hi));
            WR[(size_t)e * 1024 + k] = (bf16)hi; WR[(size_t)(32 + e) * 1024 + k] = (bf16)lo; }
        const float* lbl = a.in[4]; float* LB = (float*)(F.ws + WS_LB);
        for (int c = gt; c < 512; c += NT) LB[c] = frcp(1.0f + __expf(lbl[512 + c] - lbl[c]));
    }
    { const float* x = a.in[0]; const float* nw = a.in[1]; bf16* XN = (bf16*)(F.ws + WS_XN);
        f32x4 wv[4];
#pragma unroll
        for (int j = 0; j < 4; ++j) wv[j] = *((const f32x4*)nw + F.lane + 64 * j);
        const bool xown = (F.G == 256);
        const int wloc = ((int)blockIdx.x >> 3) * NWAVES + F.wave, rbase_ = SEQ * ((int)blockIdx.x & 7);
        const int nit_ = xown ? M / (256 * NWAVES) : (M - gw + NGW - 1) / NGW;
        for (int it_ = 0; it_ < nit_; ++it_) {
            const int m = xown ? rbase_ + wloc + 256 * (M / (256 * NWAVES) - 1 - it_) : gw + it_ * NGW;
            if (m >= M) break;
            const GAS f32x4* xr = (const GAS f32x4*)(x + (size_t)m * D) + F.lane;
            f32x4 v[4]; float s = 0.f;
#pragma unroll
            for (int j = 0; j < 4; ++j) { v[j] = __builtin_nontemporal_load(xr + 64 * j); s += (v[j].x * v[j].x + v[j].y * v[j].y) + (v[j].z * v[j].z + v[j].w * v[j].w); }
            const float rstd = 1.0f / sqrtf(wave_sum(s) * (1.f / D) + RMS_EPS);
            GAS unsigned long long* o8 = (GAS unsigned long long*)(XN + (size_t)m * D) + F.lane;
#pragma unroll
            for (int j = 0; j < 4; ++j) { const f32x4 y = v[j] * rstd * wv[j]; o8[64 * j] = (unsigned long long)pk2(y.x, y.y) | ((unsigned long long)pk2(y.z, y.w) << 32); }
        }
    }
}

typedef float f32x16 __attribute__((ext_vector_type(16)));
typedef short s16x4 __attribute__((ext_vector_type(4)));
typedef short v4i16_t __attribute__((ext_vector_type(4)));
__device__ __forceinline__ s16x4 ds_tr16(const LAS unsigned char* p) { return __builtin_bit_cast(s16x4, __builtin_amdgcn_ds_read_tr16_b64_v4i16((LAS v4i16_t*)p)); }
__device__ __forceinline__ float xhalf_max(float v) { auto rr = __builtin_amdgcn_permlane32_swap(__float_as_uint(v), __float_as_uint(v), false, false); return fmaxf(__uint_as_float(rr[0]), __uint_as_float(rr[1])); }
__device__ __forceinline__ float xhalf_sum(float v) { auto rr = __builtin_amdgcn_permlane32_swap(__float_as_uint(v), __float_as_uint(v), false, false); return __uint_as_float(rr[0]) + __uint_as_float(rr[1]); }
__device__ __forceinline__ void attn_task2(const bf16* QA, const bf16* KA, const bf16* VA, bf16* RUN, float* LRUN, bf16* MIX, const int mode, const LAS float* tbl, LAS unsigned char* vt,
                                           const int b, const int h, const int dil, const int pos0, const int lane) {
    const int q = lane & 31, hi = lane >> 5;
    const size_t rowb = (size_t)b * SEQ;
    bf16x8 qr[2][4];
    const bf16* Qb = QA + rowb * 512 + h * 64; const bf16* Kb = KA + rowb * 512 + h * 64; const bf16* Vb = VA + rowb * 512 + h * 64;
#pragma unroll
    for (int t = 0; t < 2; ++t) { const unsigned qo = (unsigned)((pos0 + dil * (32 * t + q)) * 512 + 8 * hi);
#pragma unroll
        for (int d0 = 0; d0 < 4; ++d0) qr[t][d0] = *(const bf16x8*)(Qb + qo + 16 * d0); }
    int c0 = 0; while (pos0 + dil * (32 * c0 - 128) < 0) ++c0;
    float m[2] = {-1e30f, -1e30f}, l[2] = {0.f, 0.f}; f32x16 o0[2], o1[2];
#pragma unroll
    for (int t = 0; t < 2; ++t)
#pragma unroll
        for (int r = 0; r < 16; ++r) { o0[t][r] = 0.f; o1[t][r] = 0.f; }
    const int trrow = (lane & 15) >> 2, trcol = 16 * ((lane >> 4) & 1) + 4 * (lane & 3);
    v4u kr[4], vn[4]; bf16x8 kf[4];
    LAS unsigned char* kt = vt + 5120;
    const unsigned ro0 = (unsigned)(dil * (lane >> 3) * 512 + 8 * (lane & 7));
#define ATT_TBASE(cc, i_) ((pos0 + dil * (32 * ((cc) < c0 ? c0 : (cc)) - 128 + 8 * (i_))) * 512)
#define ATT_LOADK(cc) do { _Pragma("unroll") for (int i = 0; i < 4; ++i) kr[i] = *(const v4u*)(Kb + ATT_TBASE(cc, i) + ro0); } while (0)
#define ATT_LOADV(cc) do { _Pragma("unroll") for (int i = 0; i < 4; ++i) vn[i] = *(const v4u*)(Vb + ATT_TBASE(cc, i) + ro0); } while (0)
    ATT_LOADK(0);
#pragma unroll
    for (int c = 0; c < 6; ++c) {
        ATT_LOADV(c);
#pragma unroll
        for (int i = 0; i < 4; ++i) { const int id = lane + 64 * i; *(LAS v4u*)(kt + (id >> 3) * 144 + (id & 7) * 16) = kr[i]; }
        if (c + 1 < 6) ATT_LOADK(c + 1);
#pragma unroll
        for (int d0 = 0; d0 < 4; ++d0) kf[d0] = *(const LAS bf16x8*)(kt + q * 144 + (16 * d0 + 8 * hi) * 2);
        if (c >= c0) {
        bool staged = false;
#pragma unroll
        for (int t = 0; t < 2; ++t) { const int ct = c - t;
            if (ct >= 0 && ct <= 4) {
                f32x16 s;
#pragma unroll
                for (int g4 = 0; g4 < 4; ++g4) { const f32x4 bq = *(const LAS f32x4*)(tbl + ((ct * 4 + g4) * 64 + lane) * 4); s[4 * g4] = bq.x; s[4 * g4 + 1] = bq.y; s[4 * g4 + 2] = bq.z; s[4 * g4 + 3] = bq.w; }
#pragma unroll
                for (int d0 = 0; d0 < 4; ++d0) s = __builtin_amdgcn_mfma_f32_32x32x16_bf16(kf[d0], qr[t][d0], s, 0, 0, 0);
                float mx = -1e30f;
#pragma unroll
                for (int r = 0; r < 16; ++r) mx = fmaxf(mx, s[r]);
                mx = xhalf_max(mx);
                if (__any(mx > m[t] + 8.0f)) {
                    const float mn = fmaxf(m[t], mx), alpha = fexp2(m[t] - mn); m[t] = mn; l[t] *= alpha;
#pragma unroll
                    for (int r = 0; r < 16; ++r) { o0[t][r] *= alpha; o1[t][r] *= alpha; } }
                const float mref = m[t];
                float ps = 0.f;
#pragma unroll
                for (int r = 0; r < 16; ++r) { s[r] = fexp2(s[r] - mref); ps += s[r]; }
                l[t] += ps;
                if (!staged) { staged = true;
#pragma unroll
                    for (int i = 0; i < 4; ++i) { const int id = lane + 64 * i; *(LAS v4u*)(vt + (id >> 3) * 128 + (id & 7) * 16) = vn[i]; }
                }
#pragma unroll
                for (int ks = 0; ks < 2; ++ks) {
                    v4u pw; pw.x = pg8::cvt_pk_bf16(s[8 * ks], s[8 * ks + 1]); pw.y = pg8::cvt_pk_bf16(s[8 * ks + 2], s[8 * ks + 3]); pw.z = pg8::cvt_pk_bf16(s[8 * ks + 4], s[8 * ks + 5]); pw.w = pg8::cvt_pk_bf16(s[8 * ks + 6], s[8 * ks + 7]);
                    const bf16x8 pf = __builtin_bit_cast(bf16x8, pw);
                    const LAS unsigned char* va = vt + (16 * ks + 4 * hi + trrow) * 128 + trcol * 2;
                    s16x4 l0 = ds_tr16(va), h0 = ds_tr16(va + 8 * 128), l1 = ds_tr16(va + 64), h1 = ds_tr16(va + 64 + 8 * 128);
                    asm volatile("s_waitcnt lgkmcnt(0)" : "+v"(l0), "+v"(h0), "+v"(l1), "+v"(h1) :: "memory");
                    o0[t] = __builtin_amdgcn_mfma_f32_32x32x16_bf16((bf16x8){l0[0], l0[1], l0[2], l0[3], h0[0], h0[1], h0[2], h0[3]}, pf, o0[t], 0, 0, 0);
                    o1[t] = __builtin_amdgcn_mfma_f32_32x32x16_bf16((bf16x8){l1[0], l1[1], l1[2], l1[3], h1[0], h1[1], h1[2], h1[3]}, pf, o1[t], 0, 0, 0);
                }
            } }
        }
    }
#undef ATT_LOADK
#undef ATT_LOADV
#undef ATT_TBASE
    bf16* RUNb = RUN + rowb * 512 + h * 64; float* LRUNb = LRUN + rowb * 8 + h; bf16* MIXb = MIX + rowb * 1024 + h * 64;
#pragma unroll
    for (int t = 0; t < 2; ++t) {
        const float lt = xhalf_sum(l[t]); const float inv = frcp(lt);
#pragma unroll
        for (int g = 0; g < 4; ++g) {
            v2u w0, w1;
            w0.x = pg8::cvt_pk_bf16(o0[t][4 * g] * inv, o0[t][4 * g + 1] * inv); w0.y = pg8::cvt_pk_bf16(o0[t][4 * g + 2] * inv, o0[t][4 * g + 3] * inv);
            w1.x = pg8::cvt_pk_bf16(o1[t][4 * g] * inv, o1[t][4 * g + 1] * inv); w1.y = pg8::cvt_pk_bf16(o1[t][4 * g + 2] * inv, o1[t][4 * g + 3] * inv);
            *(LAS v2u*)(vt + q * 144 + (8 * g + 4 * hi) * 2) = w0; *(LAS v2u*)(vt + q * 144 + (32 + 8 * g + 4 * hi) * 2) = w1;
        }
        if (hi == 0) *(LAS float*)(vt + 4608 + q * 4) = m[t] + __builtin_amdgcn_logf(lt);
        v4u rv[4]; float rl[4];
        if (mode > 0) {
#pragma unroll
            for (int i = 0; i < 4; ++i) { const int row = 8 * i + (lane >> 3), ch = lane & 7; const unsigned ro = (unsigned)(pos0 + dil * (32 * t + row));
                rv[i] = *(const v4u*)(RUNb + (unsigned)(ro * 512 + 8 * ch)); rl[i] = LRUNb[(unsigned)(ro * 8)]; } }
        asm volatile("s_waitcnt lgkmcnt(0)" ::: "memory");
#pragma unroll
        for (int i = 0; i < 4; ++i) { const int row = 8 * i + (lane >> 3), ch = lane & 7; const unsigned ro = (unsigned)(pos0 + dil * (32 * t + row));
            v4u v = *(const LAS v4u*)(vt + row * 144 + ch * 16); float ln = *(const LAS float*)(vt + 4608 + row * 4);
            if (mode > 0) { const float mx = fmaxf(ln, rl[i]), wn0 = fexp2(ln - mx), wr0 = fexp2(rl[i] - mx), sw = wn0 + wr0, iv = frcp(sw), wn = wn0 * iv, wr = wr0 * iv; const v4u r = rv[i];
                v.x = pk2(wn * bflo(v.x) + wr * bflo(r.x), wn * bfhi(v.x) + wr * bfhi(r.x)); v.y = pk2(wn * bflo(v.y) + wr * bflo(r.y), wn * bfhi(v.y) + wr * bfhi(r.y));
                v.z = pk2(wn * bflo(v.z) + wr * bflo(r.z), wn * bfhi(v.z) + wr * bfhi(r.z)); v.w = pk2(wn * bflo(v.w) + wr * bflo(r.w), wn * bfhi(v.w) + wr * bfhi(r.w));
                ln = mx + __builtin_amdgcn_logf(sw); }
            if (mode < 2) { *(v4u*)(RUNb + (unsigned)(ro * 512 + 8 * ch)) = v; if (ch == 0) LRUNb[(unsigned)(ro * 8)] = ln; }
            else *(v4u*)(MIXb + (unsigned)(ro * 1024 + 8 * ch)) = v; }
        asm volatile("s_waitcnt lgkmcnt(0)" ::: "memory");
    }
}
__device__ __forceinline__ void attn_mfma(Frame& F, const Args& a, const int rank, const int nblk) {
    LAS float* tbl = (LAS float*)F.lds;
    LAS float* xtb = (LAS float*)(F.lds + 4096 + NWAVES * 9728);
    LAS unsigned char* vt = F.lds + 4096 + F.wave * 9728;
    const float* rel = a.in[3];
    const bf16* QA = (const bf16*)(F.ws + WS_PROJ); const bf16* KA = QA + PROJ_STRIDE; const bf16* VA = QA + 2 * PROJ_STRIDE;
    bf16* ATTP = (bf16*)(F.ws + WS_ATTP); float* LSE = (float*)(F.ws + WS_LSE); bf16* MIX = (bf16*)(F.ws + WS_MIX);
    for (int u = rank; u < 256; u += nblk) {
        const int bh = u >> 2, span = u & 3, b = bh >> 3, h = bh & 7, P0 = span * 1024;
        for (int idx = F.tid; idx < 3 * 192; idx += NWAVES * 64) { const int p = idx / 192, jj = idx % 192 - 32;
            tbl[idx] = (jj >= 0 && jj <= 128) ? rel[(int)a.bkt[p][jj] * 8 + h] * LOG2E : -1e30f; }
        __syncthreads();
        for (int idx = F.tid; idx < 3 * 5 * 4 * 64; idx += NWAVES * 64) { const int ln = idx & 63, g4 = (idx >> 6) & 3, ct = (idx >> 8) % 5, p = idx / 1280, q_ = ln & 31, hi_ = ln >> 5;
            f32x4 v;
#pragma unroll
            for (int e = 0; e < 4; ++e) { const int r = 4 * g4 + e, kv = (r & 3) + 8 * (r >> 2) + 4 * hi_; v[e] = tbl[p * 192 + 160 - 32 * ct + q_ - kv]; }
            *(LAS f32x4*)(xtb + (size_t)idx * 4) = v; }
        __syncthreads();
#pragma unroll 1
        for (int p = 0; p < 3; ++p) {
            const int dil = (p == 0) ? 1 : (p == 1 ? 4 : 16), ppr = 16 / dil;
            for (int kk = 0; kk < 2; ++kk) { const int ix = (F.wave + 8 * kk) , r = ix / ppr, j = ix % ppr;
                attn_task2(QA, KA, VA, ATTP, LSE, MIX, p, xtb + p * 5120, vt, b, h, dil, P0 + r + dil * 64 * j, F.lane); }
            VM_WAIT();
            __syncthreads();
        }
    }
}

constexpr int HPB = 272;
constexpr int H_QE = 0, H_KD = H_QE + 64 * HPB, H_KS = H_KD + 64 * HPB, H_I = H_KS + 64 * HPB, H_QJ = H_I + 64 * HPB, H_AB = H_QJ + 160 * HPB, H_TQ = H_AB + 64 * 144, H_EL = H_TQ + 8192;
constexpr int H_O = RING_BYTES;
static_assert(H_EL + 512 <= RING_BYTES && H_O + 64 * HPB <= TAB_OFF, "hgrn LDS map");
constexpr size_t WS_US = WS_HO, WS_DV = WS_HO + 32 * MiB;
__device__ __forceinline__ f32x4 exp4(f32x4 x) { return (f32x4){fexp2(x.x * LOG2E), fexp2(x.y * LOG2E), fexp2(x.z * LOG2E), fexp2(x.w * LOG2E)}; }
__device__ __forceinline__ v2u pack4(f32x4 v) { v2u r; r.x = pg8::cvt_pk_bf16(v.x, v.y); r.y = pg8::cvt_pk_bf16(v.z, v.w); return r; }
__device__ __forceinline__ f32x4 unpack4(v2u w) { return (f32x4){bflo(w.x), bfhi(w.x), bflo(w.y), bfhi(w.y)}; }
constexpr int G_T0 = 0, G_TSZ = 3 * 64 * HPB, G_TQ = 2 * G_TSZ, G_ET = G_TQ + 2 * 8192, G_END = G_ET + 2 * 2048;
static_assert(G_END <= RING_BYTES, "hgrn2 LDS map");
constexpr int H_NSC = 8, H_CPS = SEQ / 64 / H_NSC;
template <int MODE>
__device__ __forceinline__ void hgrn_units2(Frame& F, const Args& a, const int rank, const int nblk) {
    const bf16* QH = (const bf16*)(F.ws + WS_PROJ) + 3 * PROJ_STRIDE; const bf16* FA = QH + PROJ_STRIDE; const bf16* IH = QH + 2 * PROJ_STRIDE; const bf16* GH = QH + 3 * PROJ_STRIDE;
    float* US = (float*)(F.ws + WS_US); float* DV = (float*)(F.ws + WS_DV); bf16* MIX = (bf16*)(F.ws + WS_MIX);
    LAS unsigned char* L = F.lds;
    const int tid = F.tid, lane = F.lane, w = F.wave, l16 = lane & 15, g = lane >> 4;
    const int kq = tid & 31, tq = tid >> 5, I = tq >> 2;
    for (int u = rank; u < BATCH * HH * H_NSC; u += nblk) {
        const int bh = u & 31, sc = u >> 5, b = bh >> 2, h = bh & 3, unit = bh * H_NSC + sc;
        f32x4 S[8];
        if (MODE == 1) {
#pragma unroll
            for (int kt = 0; kt < 8; ++kt) S[kt] = *(const f32x4*)(US + (size_t)unit * 16384 + w * 2048 + kt * 256 + lane * 4);
        } else {
#pragma unroll
            for (int kt = 0; kt < 8; ++kt) S[kt] = (f32x4){0.f, 0.f, 0.f, 0.f};
        }
        f32x4 sumlast = {0.f, 0.f, 0.f, 0.f};
        const size_t base = ((size_t)b * SEQ + 64 * H_CPS * sc) * 512 + h * 128;
        v2u na[4], nq[4], ni[4];
        f32x4 loc[4], kkv[4], qv[4]; v2u ri[4];
#define G_LOAD(cc) do { _Pragma("unroll") for (int j = 0; j < 4; ++j) { const size_t off_ = base + (size_t)(64 * (cc) + 4 * tq + j) * 512 + 4 * kq; \
            na[j] = __builtin_nontemporal_load((const v2u*)(FA + off_)); if (MODE == 1) nq[j] = __builtin_nontemporal_load((const v2u*)(QH + off_)); ni[j] = __builtin_nontemporal_load((const v2u*)(IH + off_)); } } while (0)
#define G_STAGE_A(buf) do { f32x4 av_[4]; _Pragma("unroll") for (int j = 0; j < 4; ++j) { av_[j] = unpack4(na[j]); if (MODE == 1) qv[j] = unpack4(nq[j]); ri[j] = ni[j]; \
                kkv[j] = (f32x4){1.f, 1.f, 1.f, 1.f} - exp4(av_[j]); } \
            loc[0] = av_[0]; loc[1] = loc[0] + av_[1]; loc[2] = loc[1] + av_[2]; loc[3] = loc[2] + av_[3]; \
            *(LAS f32x4*)(L + G_TQ + (buf) * 8192 + (tq * 128 + 4 * kq) * 4) = loc[3]; } while (0)
#define G_STAGE_B(buf) do { LAS unsigned char* T_ = L + (buf) * G_TSZ; const LAS unsigned char* Q_ = L + G_TQ + (buf) * 8192; \
            f32x4 mypre = {0.f, 0.f, 0.f, 0.f}, tot = mypre; \
            _Pragma("unroll") for (int i = 0; i < 4; ++i) { const f32x4 x_ = *(const LAS f32x4*)(Q_ + ((4 * I + i) * 128 + 4 * kq) * 4); mypre = ((4 * I + i) < tq) ? mypre + x_ : mypre; tot += x_; } \
            if ((tq & 3) == 0) *(LAS f32x4*)(L + G_ET + (buf) * 2048 + (I * 128 + 4 * kq) * 4) = exp4(tot); \
            if (MODE == 0 && tq == 0) { _Pragma("unroll") for (int i = 0; i < 16; ++i) sumlast += *(const LAS f32x4*)(Q_ + (i * 128 + 4 * kq) * 4); } \
            _Pragma("unroll") for (int j = 0; j < 4; ++j) { const int t_ = 4 * tq + j; const f32x4 E_ = exp4(mypre + loc[j]); \
                f32x4 R_; R_.x = fminf(frcp(E_.x), 5.0e34f); R_.y = fminf(frcp(E_.y), 5.0e34f); R_.z = fminf(frcp(E_.z), 5.0e34f); R_.w = fminf(frcp(E_.w), 5.0e34f); \
                if (MODE == 1) *(LAS v2u*)(T_ + t_ * HPB + 8 * kq) = pack4(qv[j] * E_); \
                *(LAS v2u*)(T_ + 64 * HPB + t_ * HPB + 8 * kq) = pack4(kkv[j] * R_); \
                *(LAS v2u*)(T_ + 128 * HPB + t_ * HPB + 8 * kq) = ri[j]; } } while (0)
        G_LOAD(0); G_STAGE_A(0); G_LOAD(1);
        __syncthreads();
        G_STAGE_B(0); G_STAGE_A(1);
        __syncthreads();
        for (int c = 0; c < H_CPS; ++c) {
            if (c + 2 < H_CPS) G_LOAD(c + 2);
            if (c + 1 < H_CPS) G_STAGE_B((c + 1) & 1);
            { const LAS unsigned char* T = L + (c & 1) * G_TSZ; const LAS unsigned char* TK = T + 64 * HPB; const LAS unsigned char* TI = T + 128 * HPB; const LAS unsigned char* ET = L + G_ET + (c & 1) * 2048;
#pragma unroll
              for (int I2 = 0; I2 < 4; ++I2) { const int r0 = 16 * I2;
                s16x4 ib = ds_tr16(TI + (r0 + 4 * g + (l16 >> 2)) * HPB + (16 * w + 4 * (l16 & 3)) * 2);
                s16x4 kk_[8];
#pragma unroll
                for (int kt = 0; kt < 8; ++kt) kk_[kt] = ds_tr16(TK + (r0 + 4 * g + (l16 >> 2)) * HPB + (16 * kt + 4 * (l16 & 3)) * 2);
                asm volatile("s_waitcnt lgkmcnt(0)" : "+v"(ib), "+v"(kk_[0]), "+v"(kk_[1]), "+v"(kk_[2]), "+v"(kk_[3]), "+v"(kk_[4]), "+v"(kk_[5]), "+v"(kk_[6]), "+v"(kk_[7]) :: "memory");
                const bf16x8 IB = (bf16x8){ib[0], ib[1], ib[2], ib[3], 0, 0, 0, 0};
                if (MODE == 1) {
                    f32x4 o = {0.f, 0.f, 0.f, 0.f}, AT = {0.f, 0.f, 0.f, 0.f};
#pragma unroll
                    for (int k4 = 0; k4 < 4; ++k4) {
                        const LAS unsigned char* qp = T + (r0 + l16) * HPB + (32 * k4 + 4 * g) * 2; const LAS unsigned char* kp = TK + (r0 + l16) * HPB + (32 * k4 + 4 * g) * 2;
                        const v2u ql = *(const LAS v2u*)qp, qh = *(const LAS v2u*)(qp + 32), kl = *(const LAS v2u*)kp, kh = *(const LAS v2u*)(kp + 32);
                        const bf16x8 Aq = __builtin_bit_cast(bf16x8, (v4u){ql.x, ql.y, qh.x, qh.y}), Kr = __builtin_bit_cast(bf16x8, (v4u){kl.x, kl.y, kh.x, kh.y});
                        v4u sw; { const v2u lo = pack4(S[2 * k4]), hh = pack4(S[2 * k4 + 1]); sw.x = lo.x; sw.y = lo.y; sw.z = hh.x; sw.w = hh.y; }
                        o = __builtin_amdgcn_mfma_f32_16x16x32_bf16(Aq, __builtin_bit_cast(bf16x8, sw), o, 0, 0, 0);
                        AT = __builtin_amdgcn_mfma_f32_16x16x32_bf16(Kr, Aq, AT, 0, 0, 0); }
#pragma unroll
                    for (int j = 0; j < 4; ++j) AT[j] = (4 * g + j <= l16) ? AT[j] : 0.f;
                    const v2u ap = pack4(AT);
                    o = __builtin_amdgcn_mfma_f32_16x16x32_bf16(__builtin_bit_cast(bf16x8, (v4u){ap.x, ap.y, 0u, 0u}), IB, o, 0, 0, 0);
#pragma unroll
                    for (int j = 0; j < 4; ++j) *(LAS bf16*)(L + H_O + (r0 + 4 * g + j) * HPB + (16 * w + l16) * 2) = (bf16)f2bf(o[j]);
                }
#pragma unroll
                for (int kt = 0; kt < 8; ++kt) {
                    S[kt] = __builtin_amdgcn_mfma_f32_16x16x32_bf16((bf16x8){kk_[kt][0], kk_[kt][1], kk_[kt][2], kk_[kt][3], 0, 0, 0, 0}, IB, S[kt], 0, 0, 0);
                    S[kt] = S[kt] * *(const LAS f32x4*)(ET + (I2 * 128 + 16 * kt + 4 * g) * 4); }
              } }
            if (c + 2 < H_CPS) G_STAGE_A(c & 1);
            __syncthreads();
            if (MODE == 1) {
                const float* nw = a.in[5];
#pragma unroll
                for (int it = 0; it < 2; ++it) { const int item = tid + 512 * it, t = item >> 4, v8 = (item & 15) * 8;
                    const v4u ow = *(const LAS v4u*)(L + H_O + t * HPB + v8 * 2);
                    const f32x4 o0 = {bflo(ow.x), bfhi(ow.x), bflo(ow.y), bfhi(ow.y)}, o1 = {bflo(ow.z), bfhi(ow.z), bflo(ow.w), bfhi(ow.w)};
                    float ss = (o0.x * o0.x + o0.y * o0.y) + (o0.z * o0.z + o0.w * o0.w) + (o1.x * o1.x + o1.y * o1.y) + (o1.z * o1.z + o1.w * o1.w);
                    ss += __shfl_xor(ss, 1); ss += __shfl_xor(ss, 2); ss += __shfl_xor(ss, 4); ss += __shfl_xor(ss, 8);
                    const float rstd = 1.0f / sqrtf(ss * (1.f / 128.f) + RMS_EPS);
                    const size_t row = (size_t)b * SEQ + 64 * H_CPS * sc + 64 * c + t;
                    const v4u gw = __builtin_nontemporal_load((const v4u*)(GH + row * 512 + h * 128 + v8));
                    const f32x4 w0 = *(const f32x4*)(nw + v8), w1 = *(const f32x4*)(nw + v8 + 4);
                    const f32x4 y0 = o0 * rstd * w0, y1 = o1 * rstd * w1;
                    v4u o; o.x = pk2(y0.x * bflo(gw.x), y0.y * bfhi(gw.x)); o.y = pk2(y0.z * bflo(gw.y), y0.w * bfhi(gw.y)); o.z = pk2(y1.x * bflo(gw.z), y1.y * bfhi(gw.z)); o.w = pk2(y1.z * bflo(gw.w), y1.w * bfhi(gw.w));
                    *(v4u*)(MIX + row * 1024 + 512 + h * 128 + v8) = o; }
                __syncthreads();
            }
        }
#undef G_LOAD
#undef G_STAGE_A
#undef G_STAGE_B
        if (MODE == 0) {
#pragma unroll
            for (int kt = 0; kt < 8; ++kt) *(f32x4*)(US + (size_t)unit * 16384 + w * 2048 + kt * 256 + lane * 4) = S[kt];
            if (tq == 0) *(f32x4*)(DV + (size_t)unit * 128 + 4 * kq) = exp4(sumlast);
        }
        __syncthreads();
    }
}

__device__ __forceinline__ void hgrn_scan(Frame& F) {
    float* US = (float*)(F.ws + WS_US); const float* DV = (const float*)(F.ws + WS_DV);
    const int gt = (F.vcu * NWAVES + F.wave) * 64 + F.lane, NT = F.G * NWAVES * 64;
    for (int idx = gt; idx < 32 * 4096; idx += NT) { const int bh = idx >> 12, r = idx & 4095, kt = (r & 511) >> 6, ln = r & 63, kb = 16 * kt + 4 * (ln >> 4);
        f32x4 run = {0.f, 0.f, 0.f, 0.f};
#pragma unroll 4
        for (int sc = 0; sc < H_NSC; ++sc) { const size_t unit = (size_t)bh * H_NSC + sc; float* p = US + unit * 16384 + (size_t)r * 4;
            const f32x4 uu = __builtin_nontemporal_load((const f32x4*)p), d = *(const f32x4*)(DV + unit * 128 + kb);
            *(f32x4*)p = run; run = d * run + uu; }
    }
}

constexpr int CV_GU = NE * 16 * 64, CV_DN = NE * 16 * 32;
__device__ __forceinline__ int dn_early(const int G) { const int n = 64 * G; return n < CV_DN ? n : CV_DN; }
__device__ __forceinline__ void moe_dn_item_fp8(Frame& F, const Args& a, const int it, LAS float* scr) {
    const int e = it / (16 * 32), q = it % (16 * 32);
    p0_transpose_item_fp8(a.in[12] + (size_t)e * 1024 * 1024, D, D, F.ws + WS_WDN + (size_t)e * 1024 * 1024, q / 32, q % 32, 32 * (q % 32), scr, F.lane);
}
#define CV_LOAD(w, it_) do { const int e_ = (it_) / 512, q_ = (it_) % 512; const float* s_ = a.in[12] + (size_t)e_ * 1024 * 1024 + (size_t)(64 * (q_ / 32) + (lane >> 5)) * 1024 + 32 * (q_ % 32) + (lane & 31); \
        _Pragma("unroll") for (int i = 0; i < 32; ++i) w[i] = __builtin_nontemporal_load(s_ + (size_t)(2 * i) * 1024); } while (0)
#define CV_FINISH(w, it_) do { const int e_ = (it_) / 512, q_ = (it_) % 512; unsigned char* d_ = F.ws + WS_WDN + (size_t)e_ * 1024 * 1024 + (size_t)(32 * (q_ % 32)) * 1024 + 64 * (q_ / 32); \
        _Pragma("unroll") for (int i = 0; i < 32; ++i) scr[(2 * i + (lane >> 5)) * 33 + (lane & 31)] = w[i]; \
        LDS_WAIT(); asm volatile("" ::: "memory"); \
        _Pragma("unroll") for (int j = 0; j < 4; ++j) { const int n = (lane >> 3) + 8 * j; const LAS float* sp = scr + (8 * (lane & 7)) * 33 + n; \
            v2u o; o.x = pk4_fp8(sp[0 * 33] * W8S, sp[1 * 33] * W8S, sp[2 * 33] * W8S, sp[3 * 33] * W8S); o.y = pk4_fp8(sp[4 * 33] * W8S, sp[5 * 33] * W8S, sp[6 * 33] * W8S, sp[7 * 33] * W8S); \
            __builtin_nontemporal_store(o, (GAS v2u*)(d_ + (size_t)n * 1024 + 8 * (lane & 7))); } \
        LDS_WAIT(); asm volatile("" ::: "memory"); } while (0)
__device__ __forceinline__ void moe_dn_filler(Frame& F, const Args& a, const int ph, const bool before) {
    const int G = F.G, c = (int)blockIdx.x, g = (c >> 3) % 5, lane = F.lane;
    LAS float* scr = (LAS float*)(F.lds + F.wave * 16384);
    const int base = ph * 32 * G + c * NWAVES + F.wave, st = NWAVES * G;
    int k = before ? 0 : g, k1 = before ? g : 4;
    while (k1 > k && base + (k1 - 1) * st >= CV_DN) --k1;
    if (k >= k1) return;
    float wa[32], wb[32];
    CV_LOAD(wa, base + k * st);
    for (;;) {
        const bool hb = k + 1 < k1;
        if (hb) CV_LOAD(wb, base + (k + 1) * st);
        CV_FINISH(wa, base + k * st);
        if (!hb) break;
        const bool ha = k + 2 < k1;
        if (ha) CV_LOAD(wa, base + (k + 2) * st);
        CV_FINISH(wb, base + (k + 1) * st);
        if (!ha) break;
        k += 2;
    }
}
#undef CV_LOAD
#undef CV_FINISH
__device__ __forceinline__ void moe_weights_to_fp8(Frame& F, const Args& a) {
    LAS float* scr = (LAS float*)(F.lds + F.wave * 16384);
    const int gw = F.vcu * NWAVES + F.wave, NGW = F.G * NWAVES, early = dn_early(F.G);
    const float* w_gu = a.in[10]; unsigned char* WGU = F.ws + WS_WGU;
    constexpr int I_GU1 = 16 * 64;
    for (int it = gw; it < CV_GU + CV_DN - early; it += NGW) {
        if (it < CV_GU) { const int e = it / I_GU1, q = it % I_GU1, kb = q / 64, nb = q % 64, n0 = 32 * nb;
            const int dst = (n0 < 1024) ? (256 * (n0 >> 7) + (n0 & 127)) : (256 * ((n0 - 1024) >> 7) + 128 + ((n0 - 1024) & 127));
            p0_transpose_item_fp8(w_gu + (size_t)e * 1024 * 2048, D, 2048, WGU + (size_t)e * 2048 * 1024, kb, nb, dst, scr, F.lane); continue; }
        moe_dn_item_fp8(F, a, it - CV_GU + early, scr);
    }
}
__device__ __forceinline__ int moe_pos(const int G) { const int c = (int)blockIdx.x, k = c >> 3; return (G % 16 == 0) ? (k & 1) * (G / 2) + (k >> 1) * 8 + (c & 7) : c; }
__device__ __forceinline__ void moe_stagger(Frame& F) {
    const int T = ((const LAS int*)(F.lds + CNT_OFF))[33], G = F.G, rem = T % G, i = moe_pos(G) - rem;
    if (rem == 0 || i < 0) return;
    const int slack = G - rem, h = (G / 2 < slack) ? G / 2 : slack;
    if (((i + 1) * h) / slack != (i * h) / slack) { __builtin_amdgcn_s_sleep(127); __builtin_amdgcn_s_sleep(127); __builtin_amdgcn_s_sleep(74); }
}
__device__ __forceinline__ void router_phase(Frame& F, const Args& a) {
    LAS int* lcnt = (LAS int*)F.lds;
    LAS int* lbase = lcnt + 32;
    LAS float* lg = (LAS float*)(F.lds + 1024) + F.wave * (16 * 33 + 16);
    const bf16* H = (const bf16*)(F.ws + WS_HB); const float* nf = a.in[7]; const float* rb = a.in[9];
    const bf16* WR = (const bf16*)(F.ws + WS_WR); unsigned char* XQ = F.ws + WS_XN;
    int* TOK = (int*)(F.ws + WS_TOK); int* SLOT = (int*)(F.ws + WS_SLOT); float* GATE = (float*)(F.ws + WS_GATE); float* RS = (float*)(F.ws + WS_RS);
    const int lane = F.lane, r16 = lane & 15, g = lane >> 4;
    LAS unsigned char* wl = F.lds + 18432;
    for (int c = F.tid; c < 64 * 128; c += NWAVES * 64) { const int row = c >> 7, ch = c & 127; *(LAS v4u*)(wl + row * 2064 + ch * 16) = *(const v4u*)(WR + (size_t)row * 1024 + ch * 8); }
    const LAS unsigned char* wlane = wl + r16 * 2064 + g * 16;
    for (int tb = blockIdx.x; tb < M / 128; tb += F.G) {
        if (F.tid < 32) lcnt[F.tid] = 0;
        __syncthreads();
        const int t0 = tb * 128 + F.wave * 16;
        const bf16* hp = H + (size_t)(t0 + r16) * D + 8 * g;
        unsigned char* xo = XQ + (size_t)(t0 + r16) * D + 8 * g;
        f32x4 acc0 = {0.f, 0.f, 0.f, 0.f}, acc1 = {0.f, 0.f, 0.f, 0.f}; float ssq = 0.f;
#pragma unroll 4
        for (int s2 = 0; s2 < 32; s2 += 2) { v2u q8[2];
#pragma unroll
          for (int hh = 0; hh < 2; ++hh) { const int s = s2 + hh;
            const v4u xw = __builtin_nontemporal_load((const v4u*)(hp + 32 * s));
            const f32x4 x0 = {bflo(xw.x), bfhi(xw.x), bflo(xw.y), bfhi(xw.y)}, x1 = {bflo(xw.z), bfhi(xw.z), bflo(xw.w), bfhi(xw.w)};
            const f32x4 w0 = *(const f32x4*)(nf + 32 * s + 8 * g), w1 = *(const f32x4*)(nf + 32 * s + 8 * g + 4);
            ssq += (x0.x * x0.x + x0.y * x0.y) + (x0.z * x0.z + x0.w * x0.w) + (x1.x * x1.x + x1.y * x1.y) + (x1.z * x1.z + x1.w * x1.w);
            const f32x4 v0 = x0 * w0, v1 = x1 * w1;
            v4u ah, al;
            ah.x = pg8::cvt_pk_bf16(v0[0], v0[1]); ah.y = pg8::cvt_pk_bf16(v0[2], v0[3]); ah.z = pg8::cvt_pk_bf16(v1[0], v1[1]); ah.w = pg8::cvt_pk_bf16(v1[2], v1[3]);
            al.x = pg8::cvt_pk_bf16(v0[0] - bflo(ah.x), v0[1] - bfhi(ah.x)); al.y = pg8::cvt_pk_bf16(v0[2] - bflo(ah.y), v0[3] - bfhi(ah.y));
            al.z = pg8::cvt_pk_bf16(v1[0] - bflo(ah.z), v1[1] - bfhi(ah.z)); al.w = pg8::cvt_pk_bf16(v1[2] - bflo(ah.w), v1[3] - bfhi(ah.w));
            q8[hh] = (v2u){pk4_fp8(v0[0] * X8S, v0[1] * X8S, v0[2] * X8S, v0[3] * X8S), pk4_fp8(v1[0] * X8S, v1[1] * X8S, v1[2] * X8S, v1[3] * X8S)};
            const bf16x8 fah = __builtin_bit_cast(bf16x8, ah), fal = __builtin_bit_cast(bf16x8, al);
            const bf16x8 bh0 = *(const LAS bf16x8*)(wlane + 64 * s), bh1 = *(const LAS bf16x8*)(wlane + 16 * 2064 + 64 * s);
            const bf16x8 bl0 = *(const LAS bf16x8*)(wlane + 32 * 2064 + 64 * s), bl1 = *(const LAS bf16x8*)(wlane + 48 * 2064 + 64 * s);
            acc0 = __builtin_amdgcn_mfma_f32_16x16x32_bf16(fah, bh0, acc0, 0, 0, 0); acc0 = __builtin_amdgcn_mfma_f32_16x16x32_bf16(fal, bh0, acc0, 0, 0, 0); acc0 = __builtin_amdgcn_mfma_f32_16x16x32_bf16(fah, bl0, acc0, 0, 0, 0);
            acc1 = __builtin_amdgcn_mfma_f32_16x16x32_bf16(fah, bh1, acc1, 0, 0, 0); acc1 = __builtin_amdgcn_mfma_f32_16x16x32_bf16(fal, bh1, acc1, 0, 0, 0); acc1 = __builtin_amdgcn_mfma_f32_16x16x32_bf16(fah, bl1, acc1, 0, 0, 0);
                  }
          *(pg8::u32x4*)(xo + 32 * (s2 + (g & 1)) + 8 * (g & 2) - 8 * g) = pg8::widen16(q8[0], q8[1]);
        }
        ssq += __shfl_xor(ssq, 16); ssq += __shfl_xor(ssq, 32);
        const float rstd = 1.0f / sqrtf(ssq * (1.f / D) + RMS_EPS);
#pragma unroll
        for (int j = 0; j < 4; ++j) { lg[(4 * g + j) * 33 + r16] = acc0[j]; lg[(4 * g + j) * 33 + 16 + r16] = acc1[j]; }
        if (lane < 16) lg[16 * 33 + lane] = rstd;
        LDS_WAIT(); asm volatile("" ::: "memory");
        int se[4] = {0, 0, 0, 0}, sp[4] = {0, 0, 0, 0}; float sg[4] = {0.f, 0.f, 0.f, 0.f}; float myr = 0.f;
        if (lane < 16) {
            myr = lg[16 * 33 + lane];
            float lv[32];
#pragma unroll
            for (int e = 0; e < 32; ++e) lv[e] = lg[lane * 33 + e] * myr + rb[e];
            unsigned used = 0u; float sv[4];
#pragma unroll
            for (int k = 0; k < 4; ++k) { float bv = -3.0e38f; int bi = 0;
#pragma unroll
                for (int e = 0; e < 32; ++e) { const bool ok = !((used >> e) & 1u) && lv[e] > bv; bv = ok ? lv[e] : bv; bi = ok ? e : bi; }
                used |= 1u << bi; se[k] = bi; sv[k] = bv; }
            const float e1 = __expf(sv[1] - sv[0]), e2 = __expf(sv[2] - sv[0]), e3 = __expf(sv[3] - sv[0]); const float inv = 1.0f / (1.0f + e1 + e2 + e3);
            sg[0] = inv; sg[1] = e1 * inv; sg[2] = e2 * inv; sg[3] = e3 * inv;
#pragma unroll
            for (int k = 0; k < 4; ++k) sp[k] = __hip_atomic_fetch_add(lcnt + se[k], 1, __ATOMIC_RELAXED, __HIP_MEMORY_SCOPE_WORKGROUP);
        }
        __syncthreads();
        if (F.tid < 32) lbase[F.tid] = (int)__hip_atomic_fetch_add((unsigned*)(F.ctl + CW_CNT + 64 * F.tid), (unsigned)lcnt[F.tid], RLX_AGENT);
        __syncthreads();
        if (lane < 16) { const int t = t0 + lane;
#pragma unroll
            for (int k = 0; k < 4; ++k) { const size_t p = (size_t)se[k] * ECAP + lbase[se[k]] + sp[k]; TOK[p] = t; GATE[p] = sg[k]; RS[p] = myr; SLOT[t * 4 + k] = (se[k] << 16) | (lbase[se[k]] + sp[k]); } }
        __syncthreads();
    }
}

__device__ __forceinline__ int moe_build_table(Frame& F, int nN, bool want_rows) {
    LAS int* tab = (LAS int*)(F.lds + TAB_OFF); LAS int* cl = (LAS int*)(F.lds + CNT_OFF); LAS int* rowsl = (LAS int*)(F.lds + ROWS_OFF);
    if (F.tid < 32) cl[F.tid] = (int)*(const volatile unsigned*)(F.ctl + CW_CNT + 64 * F.tid);
    __syncthreads();
    int T = 0;
    for (int e = 0; e < NE; ++e) T += ((cl[e] + 255) >> 8) * nN;
    if (F.tid == 0) cl[33] = T;
    const int G = F.G, c = moe_pos(G);
    int n = (T > c) ? (T - c + G - 1) / G : 0; if (n > MAXU) n = MAXU;
    if (F.tid < n) {
        const int L = F.tid * G + c;
        int wgid = L; { const int q = T / 8, r = T % 8, xcd = wgid % 8, off = wgid / 8; wgid = (xcd < r ? xcd * (q + 1) : r * (q + 1) + (xcd - r) * q) + off; }
        int e = NE - 1, pre = 0, rowblk = 0;
        { int run = 0, rb = 0; bool found = false;
#pragma unroll
          for (int q = 0; q < NE; ++q) { const int nM_ = (cl[q] + 255) >> 8, U = nM_ * nN; const bool hit = !found && (wgid < run + U);
              e = hit ? q : e; pre = hit ? run : pre; rowblk = hit ? rb : rowblk; found = found || hit; run += U; rb += nM_; } }
        const int nM = (cl[e] + 255) >> 8, w = wgid - pre, nig = 8 * nN, gid = w / nig, fm = gid * 8, gsz = (nM - fm) < 8 ? (nM - fm) : 8;
        const int pm = fm + ((w % nig) % gsz), pn = (w % nig) / gsz; int nv = cl[e] - pm * 256; nv = nv > 256 ? 256 : nv;
        tab[F.tid * 8 + 0] = e; tab[F.tid * 8 + 1] = pm; tab[F.tid * 8 + 2] = pn; tab[F.tid * 8 + 3] = nv; tab[F.tid * 8 + 4] = rowblk * 256;
    }
    __syncthreads();
    if (want_rows) { const int* TOK = (const int*)(F.ws + WS_TOK);
        int rv[MAXU / 2];
#pragma unroll
        for (int q = 0; q < MAXU / 2; ++q) { const int idx = F.tid + q * (NWAVES * 64), j = idx >> 8, r = idx & 255; rv[q] = 0;
            if (idx < n * 256) { const int e = tab[j * 8], pm = tab[j * 8 + 1], nv = tab[j * 8 + 3]; rv[q] = TOK[(size_t)e * ECAP + pm * 256 + (r < nv ? r : 0)]; } }
#pragma unroll
        for (int q = 0; q < MAXU / 2; ++q) { const int idx = F.tid + q * (NWAVES * 64); if (idx < n * 256) rowsl[idx] = rv[q]; }
        __syncthreads(); }
    return n;
}

__device__ __forceinline__ void final_phase(Frame& F, const Args& a) {
    const int lane_ = (int)__builtin_amdgcn_mbcnt_hi(~0u, __builtin_amdgcn_mbcnt_lo(~0u, 0u));
    float* OUT = a.out; const bf16* H = (const bf16*)(F.ws + WS_HB); const unsigned char* OB = F.ws + WS_OBUF; const float* fw = a.in[14]; const int* POS = (const int*)(F.ws + WS_SLOT);
    const int gw = F.vcu * NWAVES + F.wave, NGW = F.G * NWAVES;
    LAS int* rbase = (LAS int*)(F.lds + CNT_OFF);
    if (F.tid < NE) {
        const int padded = (((int)*(const volatile unsigned*)(F.ctl + CW_CNT + 64 * F.tid) + 255) >> 8) * 256;
        int incl = padded;
#pragma unroll
        for (int d = 1; d < NE; d <<= 1) { const int up = __shfl_up(incl, d); if (F.tid >= d) incl += up; }
        rbase[F.tid] = incl - padded; }
    __syncthreads();
    f32x4 wv[4];
#pragma unroll
    for (int j = 0; j < 4; ++j) wv[j] = *((const f32x4*)fw + lane_ + 64 * j);
    for (int m = gw; m < M; m += NGW) {
        GAS f32x4* hr = (GAS f32x4*)(OUT + (size_t)m * D) + lane_;
        const GAS v2u* hbr = (const GAS v2u*)(H + (size_t)m * D) + lane_;
        f32x4 v[4]; float s = 0.f;
#pragma unroll
        for (int j = 0; j < 4; ++j) { const v2u hw = __builtin_nontemporal_load(hbr + 64 * j); v[j] = (f32x4){bflo(hw.x), bfhi(hw.x), bflo(hw.y), bfhi(hw.y)}; }
        const v4i_t ps = *(const v4i_t*)(POS + (size_t)m * 4);
        int orow[4];
#pragma unroll
        for (int k = 0; k < 4; ++k) orow[k] = rbase[ps[k] >> 16] + (ps[k] & 0xffff);
        f32x4 y[4];
#pragma unroll
        for (int j = 0; j < 4; ++j) y[j] = (f32x4){0.f, 0.f, 0.f, 0.f};
#pragma unroll
        for (int k = 0; k < 4; ++k) { const GAS unsigned* op = (const GAS unsigned*)(OB + (size_t)orow[k] * D) + lane_;
#pragma unroll
            for (int j = 0; j < 4; ++j) { const int w = (int)__builtin_nontemporal_load(op + 64 * j);
                const f32x2 lo = __builtin_amdgcn_cvt_pk_f32_fp8(w, false), hi = __builtin_amdgcn_cvt_pk_f32_fp8(w, true);
                y[j].x += lo.x; y[j].y += lo.y; y[j].z += hi.x; y[j].w += hi.y; } }
#pragma unroll
        for (int j = 0; j < 4; ++j) v[j] += y[j] * (1.0f / O8S);
#pragma unroll
        for (int j = 0; j < 4; ++j) s += (v[j].x * v[j].x + v[j].y * v[j].y) + (v[j].z * v[j].z + v[j].w * v[j].w);
        const float rstd = 1.0f / sqrtf(wave_sum(s) * (1.f / D) + RMS_EPS);
#pragma unroll
        for (int j = 0; j < 4; ++j) hr[64 * j] = v[j] * rstd * wv[j];
    }
}

__global__ void __launch_bounds__(NWAVES * 64, 2) fwd_kernel(Args args) {
    extern __shared__ __attribute__((aligned(16))) unsigned char lds[];
    Frame F;
    F.lds = (LAS unsigned char*)lds;
    F.MISC = (volatile LAS unsigned*)(F.lds + MISC_OFF);
    F.tid = threadIdx.x; F.lane = F.tid & 63; F.wave = __builtin_amdgcn_readfirstlane(F.tid >> 6);
    F.G = gridDim.x; { const int bx = blockIdx.x; F.vcu = (F.G % 8 == 0) ? (bx % 8) * (F.G / 8) + bx / 8 : bx; }
    F.ws = args.ws; F.ctl = (gu32*)(args.ws + WS_CTL);
    if (F.tid < 32) F.MISC[F.tid] = 0u;
    __syncthreads();
    XcdBarrier bar = xcd_barrier_post((unsigned*)(F.ctl + CW_BAR), F.MISC + 8);
    const int lo = args.ph_lo, hi = args.ph_hi;
#define IN(k) (lo <= (k) && (k) < hi)
#define BOTH(k) (IN(k) && IN((k) + 1))
#define GRID_BAR() xcd_barrier(bar)

#ifndef DUP_PHASE
#define DUP_PHASE (-1)
#endif
#define PHASE_BEGIN(k) if (IN(k)) { for (int rep_ = 0; rep_ < ((DUP_PHASE == (k)) ? 2 : 1); ++rep_) { if (rep_) GRID_BAR();
#define PHASE_END(k) } if (BOTH(k)) GRID_BAR(); }
    PHASE_BEGIN(0) p0_prologue(F, args); PHASE_END(0)
    PHASE_BEGIN(1)
        pg8::DenseOrder S; S.init(F.ws + WS_XN, F.ws + WS_WIN, M, NPROJ, D, F.G, (int)blockIdx.x);
        pg8::EpiInProj E{(bf16*)(F.ws + WS_PROJ), (const float*)(F.ws + WS_LB)};
        moe_dn_filler(F, args, 0, true); __syncthreads();
        pg8::gemm_phase<pg8::EpiInProj, pg8::DenseOrder, false, true>(F.lds, D, S, E);
        moe_dn_filler(F, args, 0, false);
    PHASE_END(1)
    const int hrank = (F.G == 256) ? (((int)blockIdx.x & 7) * 4 + (((int)blockIdx.x >> 3) & 3)) + 32 * ((int)blockIdx.x >> 5) : (int)blockIdx.x;
    PHASE_BEGIN(2) hgrn_units2<0>(F, args, hrank, F.G); attn_mfma(F, args, F.vcu, F.G); PHASE_END(2)
    PHASE_BEGIN(3) hgrn_scan(F); PHASE_END(3)
    PHASE_BEGIN(4) hgrn_units2<1>(F, args, hrank, F.G); PHASE_END(4)
    PHASE_BEGIN(5)
        pg8::DenseOrder S; S.init(F.ws + WS_MIX, F.ws + WS_WOUT, M, D, D, F.G, (int)blockIdx.x);
        pg8::EpiOutProj E{args.in[0], (bf16*)(F.ws + WS_HB)};
        moe_dn_filler(F, args, 1, true); __syncthreads();
        pg8::gemm_phase<pg8::EpiOutProj, pg8::DenseOrder, false, true>(F.lds, D, S, E);
        moe_dn_filler(F, args, 1, false);
    PHASE_END(5)
    PHASE_BEGIN(6) moe_weights_to_fp8(F, args); __syncthreads(); router_phase(F, args); PHASE_END(6)
    PHASE_BEGIN(7)
        const int n = moe_build_table(F, 8, true);
        pg8::MoeOrder S{(const LAS int*)(F.lds + TAB_OFF), (const LAS int*)(F.lds + ROWS_OFF), n, (const char*)(F.ws + WS_XN), (const char*)(F.ws + WS_WGU), (size_t)2048 * 1024, D / 2, true};
        pg8::EpiSwiglu E{F.ws + WS_ACT, args.in[11], (const float*)(F.ws + WS_RS)};
        moe_stagger(F);
        pg8::gemm_phase<pg8::EpiSwiglu, pg8::MoeOrder, true, true, true>(F.lds, D / 2, S, E, F.lds + CB_OFF);
    PHASE_END(7)
    PHASE_BEGIN(8)
        const int n = moe_build_table(F, 4, false);
        pg8::MoeOrder S{(const LAS int*)(F.lds + TAB_OFF), (const LAS int*)(F.lds + ROWS_OFF), n, (const char*)(F.ws + WS_ACT), (const char*)(F.ws + WS_WDN), (size_t)1024 * 1024, D / 2, false};
        pg8::EpiDown E{F.ws + WS_OBUF, args.in[13], (const float*)(F.ws + WS_GATE)};
        moe_stagger(F);
        pg8::gemm_phase<pg8::EpiDown, pg8::MoeOrder, false, true, true>(F.lds, D / 2, S, E, F.lds + CB_OFF);
    PHASE_END(8)
    PHASE_BEGIN(9) final_phase(F, args); PHASE_END(9)
#undef IN
#undef BOTH
#undef GRID_BAR
}


#ifndef MK_N_LAUNCHES
#define MK_N_LAUNCHES 1
#endif
static void fill_buckets(Args& a) {
    const int dil[3] = {1, 4, 16};
    for (int p = 0; p < 3; ++p) for (int j = 0; j < 136; ++j) {
        int bkt = 0;
        if (j <= 128) { const int n = j * dil[p];
            if (n < 16) bkt = n;
            else { int large = 16 + (int)(std::log((double)n / 16.0) / std::log(2048.0 / 16.0) * 16.0); bkt = large < 31 ? large : 31; } }
        a.bkt[p][j] = (unsigned char)bkt; }
}
extern "C" void kernel_launch(void* const* d_in, const int* in_sizes, int n_in, void* d_out, int out_size, void* d_ws, size_t ws_size, hipStream_t stream) {
    static int grid = 0;
    if (grid == 0) {
        if (n_in != 15 || in_sizes[0] != M * D || out_size != M * D || ws_size < WS_END) { fprintf(stderr, "kernel_launch: unexpected shapes / workspace (n_in %d, ws %zu < %zu); nothing launched\n", n_in, ws_size, (size_t)WS_END); grid = -1; return; }
        int dev = 0, cus = 0;
        if (hipGetDevice(&dev) != hipSuccess || hipDeviceGetAttribute(&cus, hipDeviceAttributeMultiprocessorCount, dev) != hipSuccess) { grid = -1; return; }
        if (hipFuncSetAttribute((const void*)fwd_kernel, hipFuncAttributeMaxDynamicSharedMemorySize, LDS_BYTES) != hipSuccess) { fprintf(stderr, "kernel_launch: hipFuncSetAttribute failed\n"); grid = -1; return; }
        int per_cu = 0;
        if (hipOccupancyMaxActiveBlocksPerMultiprocessor(&per_cu, (const void*)fwd_kernel, NWAVES * 64, LDS_BYTES) != hipSuccess || per_cu < 1) fprintf(stderr, "kernel_launch: occupancy query says %d\n", per_cu);
        (void)hipGetLastError();
        grid = cus;
    }
    if (grid < 0) return;
    if (hipMemsetAsync((char*)d_ws + WS_CTL, 0, CTL_ZERO_BYTES, stream) != hipSuccess) return;
    Args a{};
    for (int i = 0; i < 15; ++i) a.in[i] = (const float*)d_in[i];
    a.out = (float*)d_out; a.ws = (unsigned char*)d_ws;
    fill_buckets(a);
    constexpr int NPH = 10;
#if MK_N_LAUNCHES == 1
    a.ph_lo = 0; a.ph_hi = NPH;
    hipLaunchKernelGGL(fwd_kernel, dim3(grid), dim3(NWAVES * 64), LDS_BYTES, stream, a);
#else
    for (int p = 0; p < NPH; ++p) { a.ph_lo = p; a.ph_hi = p + 1; hipLaunchKernelGGL(fwd_kernel, dim3(grid), dim3(NWAVES * 64), LDS_BYTES, stream, a); }
#endif
}
```
